# Optimizing an MI355X kernel written in HIP

```python
import math
import jax, jax.numpy as jnp
from jax import lax
import numpy as np

D_MODEL = 1024
BATCH = 8
SEQ = 4096
DEPTH = 2
DEC_BATCH = 32
DEC_SEQ = 32
PAST_LEN = 4096

CHUNK = 64
BAND_CHUNKS = 8
WINDOW_A = BAND_CHUNKS * CHUNK
HA = 8
DHA = 64
HB = 4
DHB = 64
HC = 4
DHC = 128
N_MEM = 256
REL_CLIP = 128
D_FF = 2816
QBLOCK = 128
D_MIX = HA * DHA + HB * 2 * DHB
D_IN = 3 * HA * DHA + 3 * HB * 2 * DHB
EPS = 1e-6
NEG_INF = -1e30

kernel_name = 'streaming_hybrid_band_diff_encoder'


def rmsnorm(x, g):
    xf = x.astype(jnp.float32)
    y = xf * lax.rsqrt(jnp.mean(xf * xf, axis=-1, keepdims=True) + EPS)
    return (y * g.astype(jnp.float32)).astype(x.dtype)


def swiglu(x, w_gu, w_dn):
    gate, up = jnp.split(x @ w_gu, 2, axis=-1)
    return (jax.nn.silu(gate) * up) @ w_dn


def ffn_half(x, g_pre, g_post, w_gu, w_dn):
    return x + 0.5 * rmsnorm(swiglu(rmsnorm(x, g_pre), w_gu, w_dn), g_post)


def alibi_slopes():
    return jnp.asarray(2.0 ** (-8.0 * np.arange(1, HB + 1) / HB), dtype=jnp.float32)


def rel_bias_lookup(table, rel):
    idx = jnp.clip(rel, -REL_CLIP, REL_CLIP) + REL_CLIP
    return table[:, idx].astype(jnp.float32)


def band_attention_prompt(q, k, v, rel_table):
    B, T = q.shape[:2]
    nc = T // CHUNK
    band = (BAND_CHUNKS + 1) * CHUNK
    qc = q.reshape(B, nc, CHUNK, HA, DHA)
    pad = ((0, 0), (WINDOW_A, 0), (0, 0), (0, 0))
    kp = jnp.pad(k, pad).reshape(B, nc + BAND_CHUNKS, CHUNK, HA, DHA)
    vp = jnp.pad(v, pad).reshape(B, nc + BAND_CHUNKS, CHUNK, HA, DHA)
    kb = jnp.concatenate([kp[:, o:o + nc] for o in range(BAND_CHUNKS + 1)], axis=2)
    vb = jnp.concatenate([vp[:, o:o + nc] for o in range(BAND_CHUNKS + 1)], axis=2)
    i = jnp.arange(CHUNK)
    j = jnp.arange(band)
    bias = rel_bias_lookup(rel_table, i[:, None] - (j[None, :] - WINDOW_A))
    k_pos = (jnp.arange(nc)[:, None] - BAND_CHUNKS) * CHUNK + j[None, :]
    s = jnp.einsum('bcqhd,bckhd->bchqk', qc, kb).astype(jnp.float32) * DHA ** -0.5 + bias
    s = jnp.where((k_pos >= 0)[None, :, None, None, :], s, NEG_INF)
    p = jax.nn.softmax(s, axis=-1)
    o = jnp.einsum('bchqk,bckhd->bcqhd', p.astype(vb.dtype), vb)
    return o.reshape(B, T, HA, DHA)


def band_attention_sample(q, k, v, cache_k, cache_v, past_len, rel_table):
    W = cache_k.shape[1]
    S = q.shape[1]
    k_all = jnp.concatenate([cache_k, k], axis=1)
    v_all = jnp.concatenate([cache_v, v], axis=1)
    q_pos = past_len + jnp.arange(S)
    k_pos = past_len - W + jnp.arange(W + S)
    bias = rel_bias_lookup(rel_table, q_pos[:, None] - k_pos[None, :])
    s = jnp.einsum('bqhd,bkhd->bhqk', q, k_all).astype(jnp.float32) * DHA ** -0.5 + bias
    p = jax.nn.softmax(s, axis=-1)
    return jnp.einsum('bhqk,bkhd->bqhd', p.astype(v_all.dtype), v_all)


def diff_attention(q, k, v, q_pos, k_pos, lam):
    B, Tq = q.shape[:2]
    qb = min(QBLOCK, Tq)
    nb = Tq // qb
    q_blocks = jnp.moveaxis(q.reshape(B, nb, qb, HB, 2, DHB), 1, 0)
    pos_blocks = q_pos.reshape(nb, qb)
    k_chunk = k_pos // CHUNK
    slopes = alibi_slopes()

    def attend_block(args):
        qblk, qp = args
        s = jnp.einsum('bqhid,bkhid->bihqk', qblk, k).astype(jnp.float32) * DHB ** -0.5
        dist = jnp.abs(qp[:, None] - k_pos[None, :]).astype(jnp.float32)
        s = s - slopes[:, None, None] * dist
        visible = k_chunk[None, :] <= (qp // CHUNK)[:, None]
        s = jnp.where(visible, s, NEG_INF)
        p = jax.nn.softmax(s, axis=-1)
        a = p[:, 0] - lam * p[:, 1]
        return jnp.einsum('bhqk,bkhe->bqhe', a.astype(v.dtype), v)

    o = lax.map(attend_block, (q_blocks, pos_blocks))
    return jnp.moveaxis(o, 0, 1).reshape(B, Tq, HB, 2 * DHB)


def cross_attend(q, mem_k, mem_v):
    s = jnp.einsum('bthd,bmhd->bhtm', q, mem_k).astype(jnp.float32) * DHC ** -0.5
    p = jax.nn.softmax(s, axis=-1)
    return jnp.einsum('bhtm,bmhd->bthd', p.astype(mem_v.dtype), mem_v)


def memory_kv(mem, g, w_ckv):
    B = mem.shape[0]
    mk, mv = jnp.split(rmsnorm(mem, g) @ w_ckv, 2, axis=-1)
    return mk.reshape(B, N_MEM, HC, DHC), mv.reshape(B, N_MEM, HC, DHC)


def trunk_layer(l, x, mem_k, mem_v, cache, norm_g, w_ffn_gu, w_ffn_dn, w_in, rel_bias,
                diff_lambda, subln_g, w_out, w_cq, w_co):
    g = norm_g[l]
    x = ffn_half(x, g[0], g[1], w_ffn_gu[l, 0], w_ffn_dn[l, 0])
    u = rmsnorm(x, g[2])
    B, T = u.shape[:2]
    qa, ka, va, qb, kb, vb = jnp.split(u @ w_in[l], 6, axis=-1)
    qa = qa.reshape(B, T, HA, DHA)
    ka = ka.reshape(B, T, HA, DHA)
    va = va.reshape(B, T, HA, DHA)
    qb = qb.reshape(B, T, HB, 2, DHB)
    kb = kb.reshape(B, T, HB, 2, DHB)
    vb = vb.reshape(B, T, HB, 2 * DHB)
    lam_init = 0.8 - 0.6 * math.exp(-0.3 * l)
    lp = diff_lambda[l].astype(jnp.float32)
    lam = jnp.exp(jnp.sum(lp[0] * lp[1])) - jnp.exp(jnp.sum(lp[2] * lp[3])) + lam_init
    if cache is None:
        oa = band_attention_prompt(qa, ka, va, rel_bias[l])
        pos = jnp.arange(T)
        ob = diff_attention(qb, kb, vb, pos, pos, lam)
        keep = min(WINDOW_A, T)
        new_state = (ka[:, T - keep:], va[:, T - keep:], kb, vb)
    else:
        ca_k, ca_v, cb_k, cb_v = cache
        past_len = cb_k.shape[1]
        oa = band_attention_sample(qa, ka, va, ca_k, ca_v, past_len, rel_bias[l])
        kb_all = jnp.concatenate([cb_k, kb], axis=1)
        vb_all = jnp.concatenate([cb_v, vb], axis=1)
        ob = diff_attention(qb, kb_all, vb_all, past_len + jnp.arange(T), jnp.arange(past_len + T), lam)
        new_state = (ka, va, kb, vb)
    ob = rmsnorm(ob, subln_g[l]) * (1.0 - lam_init)
    mix = jnp.concatenate([oa.reshape(B, T, HA * DHA), ob.reshape(B, T, HB * 2 * DHB)], axis=-1) @ w_out[l]
    x = x + rmsnorm(mix, g[3])
    qc = (rmsnorm(x, g[4]) @ w_cq[l]).reshape(B, T, HC, DHC)
    oc = cross_attend(qc, mem_k, mem_v).reshape(B, T, HC * DHC) @ w_co[l]
    x = x + rmsnorm(oc, g[5])
    x = ffn_half(x, g[6], g[7], w_ffn_gu[l, 1], w_ffn_dn[l, 1])
    return x, new_state


def setup_inputs(seed: int = 0) -> dict:
    key = jax.random.key(seed)
    ks = jax.random.split(key, 21)

    def nrm(k, shape, scale):
        return jax.random.normal(k, shape, jnp.float32) * scale

    wa = min(WINDOW_A, PAST_LEN)
    return {
        'x_prompt': nrm(ks[0], (BATCH, SEQ, D_MODEL), 1.0),
        'x_sample': nrm(ks[1], (DEC_BATCH, DEC_SEQ, D_MODEL), 1.0),
        'mem_prompt': nrm(ks[2], (BATCH, N_MEM, D_MODEL), 1.0),
        'cache_a_k': nrm(ks[3], (DEPTH, DEC_BATCH, wa, HA, DHA), 1.0),
        'cache_a_v': nrm(ks[4], (DEPTH, DEC_BATCH, wa, HA, DHA), 1.0),
        'cache_b_k': nrm(ks[5], (DEPTH, DEC_BATCH, PAST_LEN, HB, 2, DHB), 1.0),
        'cache_b_v': nrm(ks[6], (DEPTH, DEC_BATCH, PAST_LEN, HB, 2 * DHB), 1.0),
        'cache_mem_k': nrm(ks[7], (DEPTH, DEC_BATCH, N_MEM, HC, DHC), 1.0),
        'cache_mem_v': nrm(ks[8], (DEPTH, DEC_BATCH, N_MEM, HC, DHC), 1.0),
        'norm_g': 1.0 + nrm(ks[9], (DEPTH, 8, D_MODEL), 0.05),
        'w_ffn_gu': nrm(ks[10], (DEPTH, 2, D_MODEL, 2 * D_FF), D_MODEL ** -0.5),
        'w_ffn_dn': nrm(ks[11], (DEPTH, 2, D_FF, D_MODEL), D_FF ** -0.5),
        'w_in': nrm(ks[12], (DEPTH, D_MODEL, D_IN), D_MODEL ** -0.5),
        'rel_bias': nrm(ks[13], (DEPTH, HA, 2 * REL_CLIP + 1), 0.1),
        'diff_lambda': nrm(ks[14], (DEPTH, 4, DHB), 0.1),
        'subln_g': 1.0 + nrm(ks[15], (DEPTH, 2 * DHB), 0.05),
        'w_out': nrm(ks[16], (DEPTH, D_MIX, D_MODEL), D_MIX ** -0.5),
        'mem_norm_g': 1.0 + nrm(ks[17], (DEPTH, D_MODEL), 0.05),
        'w_cq': nrm(ks[18], (DEPTH, D_MODEL, HC * DHC), D_MODEL ** -0.5),
        'w_ckv': nrm(ks[19], (DEPTH, D_MODEL, 2 * HC * DHC), D_MODEL ** -0.5),
        'w_co': nrm(ks[20], (DEPTH, HC * DHC, D_MODEL), (HC * DHC) ** -0.5),
    }


def reference(x_prompt, x_sample, mem_prompt, cache_a_k, cache_a_v, cache_b_k, cache_b_v,
              cache_mem_k, cache_mem_v, norm_g, w_ffn_gu, w_ffn_dn, w_in, rel_bias, diff_lambda,
              subln_g, w_out, mem_norm_g, w_cq, w_ckv, w_co):
    xp = x_prompt
    xs = x_sample
    p_ak, p_av, p_bk, p_bv, p_mk, p_mv = [], [], [], [], [], []
    s_ak, s_av, s_bk, s_bv = [], [], [], []
    for l in range(DEPTH):
        mk, mv = memory_kv(mem_prompt, mem_norm_g[l], w_ckv[l])
        xp, st_p = trunk_layer(l, xp, mk, mv, None, norm_g, w_ffn_gu, w_ffn_dn, w_in, rel_bias,
                               diff_lambda, subln_g, w_out, w_cq, w_co)
        xs, st_s = trunk_layer(l, xs, cache_mem_k[l], cache_mem_v[l],
                               (cache_a_k[l], cache_a_v[l], cache_b_k[l], cache_b_v[l]),
                               norm_g, w_ffn_gu, w_ffn_dn, w_in, rel_bias,
                               diff_lambda, subln_g, w_out, w_cq, w_co)
        p_ak.append(st_p[0]); p_av.append(st_p[1]); p_bk.append(st_p[2]); p_bv.append(st_p[3])
        p_mk.append(mk); p_mv.append(mv)
        s_ak.append(st_s[0]); s_av.append(st_s[1]); s_bk.append(st_s[2]); s_bv.append(st_s[3])
    return (xp, xs,
            jnp.stack(p_ak), jnp.stack(p_av), jnp.stack(p_bk), jnp.stack(p_bv),
            jnp.stack(p_mk), jnp.stack(p_mv),
            jnp.stack(s_ak), jnp.stack(s_av), jnp.stack(s_bk), jnp.stack(s_bv))
```

```cpp
#include <hip/hip_runtime.h>
#include <cstdio>
#include <cstdint>

constexpr int DM = 1024, PB = 8, PT = 4096, SB = 32, ST = 32, DEPTH = 2;
constexpr int MP = PB * PT, MS = SB * ST, MTOT = MP + MS;
constexpr int DFF = 2816, NGU = 2 * DFF, NIN = 3072, NMEM = 256, MMEM = PB * NMEM, PAST = 4096, WA = 512;
constexpr float EPS = 1e-6f, LOG2E = 1.4426950408889634f;
constexpr float QS64 = 0.125f * LOG2E, QS128 = 0.08838834764831845f * LOG2E;
constexpr size_t O_Y = 0, O_PAK = (size_t)MTOT * DM, O_PAV = O_PAK + 4194304, O_PBK = O_PAV + 4194304, O_PBV = O_PBK + 33554432,
                 O_PMK = O_PBV + 33554432, O_PMV = O_PMK + 2097152, O_SAK = O_PMV + 2097152, O_SAV = O_SAK + 1048576,
                 O_SBK = O_SAV + 1048576, O_SBV = O_SBK + 1048576, O_END = O_SBV + 1048576;
static_assert(O_END == 118489088, "output size");
constexpr size_t MiB = 1u << 20;
constexpr size_t WS_CTL = 0, CTL_ZERO_BYTES = MiB;
constexpr size_t WS_WGU = 1 * MiB, WS_WDN = 45 * MiB, WS_WIN = 67 * MiB, WS_WOUT = 79 * MiB, WS_WCQ = 83 * MiB, WS_WCKV = 85 * MiB, WS_WCO = 89 * MiB;
constexpr size_t WS_XN = 92 * MiB, WS_ACT = 158 * MiB, WS_Y = 340 * MiB, WS_QKV = 406 * MiB, WS_MIX = 604 * MiB, WS_QC = 670 * MiB, WS_OC = 703 * MiB;
constexpr size_t WS_MEMN = 736 * MiB, WS_MKV = 744 * MiB, WS_OS = 752 * MiB, WS_END = 756 * MiB;
static_assert((size_t)MTOT * DFF * 2 <= WS_Y - WS_ACT && (size_t)MTOT * NIN * 2 <= WS_MIX - WS_QKV && (size_t)MTOT * DM * 2 <= WS_ACT - WS_XN, "ws map");
namespace pg8 {
#define PG8_LAS __attribute__((address_space(3)))
typedef unsigned short bf16_t;
typedef short bf16x8 __attribute__((ext_vector_type(8)));
typedef float f32x4 __attribute__((ext_vector_type(4)));
typedef unsigned u32x4 __attribute__((ext_vector_type(4)));
constexpr int BM = 256, BK = 64, HALF = 128, HTB = HALF * BK * 2  , STAGE_BYTES = 8 * HTB, NXCD = 8, WGM = 8;

__host__ __device__ __forceinline__ int lds_byte(int r, int c) { const int st = (r >> 4) * 2 + (c >> 5), rr = r & 15, cc = c & 31, ob = rr * 64 + cc * 2; return st * 1024 + (ob ^ (((ob >> 9) & 1) << 5)); }
__host__ __device__ __forceinline__ void stage_rc(int b, int& R, int& C) { const int st = b / 1024, sb = b % 1024, swz = sb ^ (((sb >> 9) & 1) << 5); R = (st >> 1) * 16 + swz / 64; C = (st & 1) * 32 + (swz % 64) / 2; }
__host__ __device__ __forceinline__ int perm32(int rho) { const int n = rho >> 4, i = rho & 15; return 8 * (i >> 2) + 4 * n + (i & 3); }

struct Unit { int pm, pn; };
struct Gemm { const bf16_t* A; const bf16_t* Bt; int M, N, K; };

struct StaticOrder {
    int nM, nN, nwg, G, c;
    __host__ __device__ void init(int M, int N, int G_, int c_) { nM = M / BM; nN = N / BM; nwg = nM * nN; G = G_; c = c_; }
    __host__ __device__ bool next(int i, Unit& u) const {
        const long L = (long)i * G + c; if (L >= nwg) return false;
        int wgid = (int)L; { const int q = nwg / NXCD, r = nwg % NXCD, xcd = wgid % NXCD, off = wgid / NXCD; wgid = (xcd < r ? xcd * (q + 1) : r * (q + 1) + (xcd - r) * q) + off; }
        const int nig = WGM * nN, gid = wgid / nig, fm = gid * WGM, gsz = (nM - fm) < WGM ? (nM - fm) : WGM;
        u.pm = fm + ((wgid % nig) % gsz); u.pn = (wgid % nig) / gsz; return true;
    }
    __device__ __forceinline__ void a_ready(const Unit&) const {}
    __device__ __forceinline__ void done(const Unit&) const {}
};

__device__ __forceinline__ unsigned cvt_pk_bf16(float lo, float hi) { unsigned r; asm volatile("v_cvt_pk_bf16_f32 %0, %1, %2" : "=v"(r) : "v"(lo), "v"(hi)); return r; }
typedef float f32x2 __attribute__((ext_vector_type(2)));

struct SubsetOrder {
    int nN, nwg, G, c;
    __device__ __forceinline__ void init(int nM_, int nN_, int G_, int c_) { nN = nN_; nwg = nM_ * nN_; G = G_; c = c_; }
    __device__ __forceinline__ bool next(int i, Unit& u) const {
        if (c < 0 || c >= G) return false;
        const long L = (long)i * G + c; if (L >= nwg) return false;
        u.pm = (int)L / nN; u.pn = (int)L % nN; return true;
    }
    __device__ __forceinline__ void a_ready(const Unit&) const {}
    __device__ __forceinline__ void done(const Unit&) const {}
};

__device__ __forceinline__ u32x4 pack8(f32x4 v0, f32x4 v1) { u32x4 w; w.x = cvt_pk_bf16(v0[0], v0[1]); w.y = cvt_pk_bf16(v0[2], v0[3]); w.z = cvt_pk_bf16(v1[0], v1[1]); w.w = cvt_pk_bf16(v1[2], v1[3]); return w; }
struct EpiPlain {
    static constexpr bool PERM = true, AFTER_DRAIN = false;
    bf16_t* O; int ldo; float scale;
    __device__ __forceinline__ void operator()(const f32x4 (&acc)[2][2][4][2], const Unit& u, int wr, int wc, int fr, int fq) const {
        const int row0 = u.pm * BM + wr * 64 + fr, col0 = u.pn * BM + wc * 32 + 8 * fq;
#pragma unroll
        for (int ai = 0; ai < 2; ++ai)
#pragma unroll
            for (int m = 0; m < 4; ++m) { bf16_t* rowp = O + (size_t)(row0 + ai * HALF + m * 16) * ldo + col0;
#pragma unroll
                for (int bj = 0; bj < 2; ++bj) *(u32x4*)(rowp + bj * HALF) = pack8(acc[ai][bj][m][0] * scale, acc[ai][bj][m][1] * scale); }
    }
};
__device__ __forceinline__ float silu_mul(float g, float u) { return g * __builtin_amdgcn_rcpf(1.0f + __builtin_amdgcn_exp2f(-1.4426950408889634f * g)) * u; }
struct EpiSwiGLU {
    static constexpr bool PERM = true, AFTER_DRAIN = false;
    bf16_t* O; int ldo;
    __device__ __forceinline__ void operator()(const f32x4 (&acc)[2][2][4][2], const Unit& u, int wr, int wc, int fr, int fq) const {
        const int row0 = u.pm * BM + wr * 64 + fr, col0 = u.pn * HALF + wc * 32 + 8 * fq;
#pragma unroll
        for (int ai = 0; ai < 2; ++ai)
#pragma unroll
            for (int m = 0; m < 4; ++m) { bf16_t* rowp = O + (size_t)(row0 + ai * HALF + m * 16) * ldo + col0;
                f32x4 a0, a1;
#pragma unroll
                for (int e = 0; e < 4; ++e) { a0[e] = silu_mul(acc[ai][0][m][0][e], acc[ai][1][m][0][e]); a1[e] = silu_mul(acc[ai][0][m][1][e], acc[ai][1][m][1][e]); }
                *(u32x4*)rowp = pack8(a0, a1); }
    }
};
struct EpiQKV {
    static constexpr bool PERM = true, AFTER_DRAIN = false;
    bf16_t* QKV; float* out; int layer;
    __device__ __forceinline__ void operator()(const f32x4 (&acc)[2][2][4][2], const Unit& u, int wr, int wc, int fr, int fq) const {
        const int seg = u.pn >> 1, hf = u.pn & 1;
        const float scale = (seg == 0 || seg == 3) ? QS64 : 1.0f;
        const int rl0 = wr * 64 + fr;
        const int colq = u.pn * BM + wc * 32 + 8 * fq, cs = hf * BM + wc * 32 + 8 * fq;
        float* sbase = nullptr;
        if (seg == 1 || seg == 2 || seg == 4 || seg == 5) {
            if (u.pm < MP / BM) {
                if (seg >= 4) sbase = out + (seg == 4 ? O_PBK : O_PBV) + ((size_t)layer * MP + (size_t)u.pm * BM) * 512;
                else if ((u.pm & 15) >= 14) sbase = out + (seg == 1 ? O_PAK : O_PAV) + ((size_t)(layer * PB + (u.pm >> 4)) * WA + (size_t)((u.pm & 15) - 14) * BM) * 512;
            } else {
                const size_t o = seg == 1 ? O_SAK : seg == 2 ? O_SAV : seg == 4 ? O_SBK : O_SBV;
                sbase = out + o + ((size_t)layer * MS + (size_t)(u.pm - MP / BM) * BM) * 512;
            }
        }
#pragma unroll
        for (int ai = 0; ai < 2; ++ai)
#pragma unroll
            for (int m = 0; m < 4; ++m) { const int rl = rl0 + ai * HALF + m * 16; bf16_t* rowp = QKV + (size_t)(u.pm * BM + rl) * NIN + colq;
#pragma unroll
                for (int bj = 0; bj < 2; ++bj) *(u32x4*)(rowp + bj * HALF) = pack8(acc[ai][bj][m][0] * scale, acc[ai][bj][m][1] * scale); }
        if (sbase) {
            float* sp0 = sbase + (size_t)rl0 * 512 + cs;
#pragma unroll
            for (int ai = 0; ai < 2; ++ai)
#pragma unroll
                for (int m = 0; m < 4; ++m)
#pragma unroll
                    for (int bj = 0; bj < 2; ++bj) { float* sp = sp0 + (ai * HALF + m * 16) * 512 + bj * HALF; *(f32x4*)sp = acc[ai][bj][m][0]; *(f32x4*)(sp + 4) = acc[ai][bj][m][1]; }
        }
    }
};
struct EpiMemKV {
    static constexpr bool PERM = true, AFTER_DRAIN = false;
    bf16_t* MKV; float* out; int layer;
    __device__ __forceinline__ void operator()(const f32x4 (&acc)[2][2][4][2], const Unit& u, int wr, int wc, int fr, int fq) const {
        const int row0 = u.pm * BM + wr * 64 + fr, col0 = u.pn * BM + wc * 32 + 8 * fq, cs = (u.pn & 1) * BM + wc * 32 + 8 * fq;
        float* sbase = out + (u.pn < 2 ? O_PMK : O_PMV) + (size_t)layer * MMEM * 512;
#pragma unroll
        for (int ai = 0; ai < 2; ++ai)
#pragma unroll
            for (int m = 0; m < 4; ++m) { const int row = row0 + ai * HALF + m * 16; bf16_t* rowp = MKV + (size_t)row * 1024 + col0;
#pragma unroll
                for (int bj = 0; bj < 2; ++bj) { *(u32x4*)(rowp + bj * HALF) = pack8(acc[ai][bj][m][0], acc[ai][bj][m][1]);
                    float* sp = sbase + (size_t)row * 512 + cs + bj * HALF; *(f32x4*)sp = acc[ai][bj][m][0]; *(f32x4*)(sp + 4) = acc[ai][bj][m][1]; } }
    }
};
template <class Epi, class Sched, bool ALIGN_EPI = false, bool SP2 = false>
__device__ __forceinline__ void gemm_phase(PG8_LAS unsigned char* lds, const Gemm g, const Sched& S, const Epi& E) {
    int tid = threadIdx.x; asm volatile("" : "+v"(tid));
    const int wid = __builtin_amdgcn_readfirstlane(tid >> 6), lane = tid & 63, wr = wid >> 2, wc = wid & 3, fr = lane & 15, fq = lane >> 4;
    const int K = g.K, nt = K / BK;
    unsigned voffA[2], voffB[2];
#pragma unroll
    for (int i = 0; i < 2; ++i) { int R, C; stage_rc(tid * 16 + i * 8192, R, C); const int Rb = Epi::PERM ? ((R & ~31) + perm32(R & 31)) : R;
        voffA[i] = (unsigned)(R * K + C) * 2u; voffB[i] = (unsigned)(Rb * K + C) * 2u; }
    const size_t kstep = (size_t)(BK * 2);
    const size_t hstep = (size_t)HALF * K * 2;
    const size_t tstep = 2 * hstep;
    const unsigned ldsw = (unsigned)wid * 1024u;
    const int aoff = lds_byte(wr * 64 + fr, fq * 8), boff = lds_byte(wc * 32 + fr, fq * 8);
#define PG8_SA(b, h) (((b) * 2 + (h)) * HTB)
#define PG8_SB(b, h) ((4 + (b) * 2 + (h)) * HTB)
#define PG8_STAGE(bufoff, gbase, voff) do { _Pragma("unroll") for (int _i = 0; _i < 2; ++_i) \
        __builtin_amdgcn_global_load_lds((const unsigned*)((const char*)(gbase) + (voff)[_i]), (PG8_LAS unsigned*)(lds + (bufoff) + ldsw + _i * 8192), 16, 0, 0); } while (0)
#define PG8_LDA(dst, b, h) do { _Pragma("unroll") for (int m = 0; m < 4; ++m) _Pragma("unroll") for (int k = 0; k < 2; ++k) dst[m][k] = *(const PG8_LAS bf16x8*)(lds + PG8_SA(b, h) + aoff + m * 2048 + k * 1024); } while (0)
#define PG8_LDB(dst, b, h) do { _Pragma("unroll") for (int n = 0; n < 2; ++n) _Pragma("unroll") for (int k = 0; k < 2; ++k) dst[n][k] = *(const PG8_LAS bf16x8*)(lds + PG8_SB(b, h) + boff + n * 2048 + k * 1024); } while (0)
#define PG8_MMA(ai, bj, At, Bt) do { __builtin_amdgcn_s_setprio(1); _Pragma("unroll") for (int m = 0; m < 4; ++m) _Pragma("unroll") for (int n = 0; n < 2; ++n) _Pragma("unroll") for (int k = 0; k < 2; ++k) \
        acc[ai][bj][m][n] = __builtin_amdgcn_mfma_f32_16x16x32_bf16(Bt[n][k], At[m][k], acc[ai][bj][m][n], 0, 0, 0); __builtin_amdgcn_s_setprio(0); } while (0)
#define PG8_WAIT_V(n) asm volatile("s_waitcnt vmcnt(" #n ")" ::: "memory")
#define PG8_WAIT_L(n) asm volatile("s_waitcnt lgkmcnt(" #n ")" ::: "memory")
#define PG8_BAR __builtin_amdgcn_s_barrier()
#define PG8_SCHED __builtin_amdgcn_sched_barrier(0)
    Unit cur, nxt; int ui = 0;
    if (!S.next(0, cur)) return;
    f32x4 acc[2][2][4][2];
#pragma unroll
    for (int a = 0; a < 2; ++a)
#pragma unroll
        for (int b = 0; b < 2; ++b)
#pragma unroll
            for (int m = 0; m < 4; ++m)
#pragma unroll
                for (int n = 0; n < 2; ++n) acc[a][b][m][n] = (f32x4){0.f, 0.f, 0.f, 0.f};
    bf16x8 At[4][2], B0[2][2], B1[2][2];
    const char* cA = (const char*)g.A + (size_t)cur.pm * tstep; const char* cB = (const char*)g.Bt + (size_t)cur.pn * tstep;
    S.a_ready(cur);
    if constexpr (SP2) {
        PG8_STAGE(PG8_SB(0, 0), cB, voffB); PG8_STAGE(PG8_SB(0, 1), cB + hstep, voffB); PG8_STAGE(PG8_SA(0, 0), cA, voffA); PG8_STAGE(PG8_SA(0, 1), cA + hstep, voffA);
        if (wr == 1) PG8_BAR;
        PG8_WAIT_V(2); PG8_BAR;
        PG8_STAGE(PG8_SB(1, 0), cB + kstep, voffB); PG8_STAGE(PG8_SA(1, 0), cA + kstep, voffA); PG8_STAGE(PG8_SB(1, 1), cB + hstep + kstep, voffB);
        PG8_WAIT_V(6); PG8_BAR;
    } else {
        PG8_STAGE(PG8_SB(0, 0), cB, voffB); PG8_STAGE(PG8_SA(0, 0), cA, voffA); PG8_STAGE(PG8_SB(0, 1), cB + hstep, voffB); PG8_STAGE(PG8_SA(0, 1), cA + hstep, voffA);
        if (wr == 1) PG8_BAR;
        PG8_WAIT_V(4); PG8_BAR;
        PG8_STAGE(PG8_SB(1, 0), cB + kstep, voffB); PG8_STAGE(PG8_SA(1, 0), cA + kstep, voffA); PG8_STAGE(PG8_SB(1, 1), cB + hstep + kstep, voffB);
        PG8_WAIT_V(6); PG8_BAR;
    }
    for (;;) {
        const bool has_next = S.next(ui + 1, nxt);
        const char* nA = has_next ? (const char*)g.A + (size_t)nxt.pm * tstep : cA; const char* nB = has_next ? (const char*)g.Bt + (size_t)nxt.pn * tstep : cB;
        for (int t = 0; t < nt; t += 2) {
            const bool last = (t == nt - 2);
            const char* a1 = cA + (size_t)(t + 1) * kstep;
            const char* a2 = last ? nA : cA + (size_t)(t + 2) * kstep; const char* b2 = last ? nB : cB + (size_t)(t + 2) * kstep;
            const char* a3 = a2 + kstep; const char* b3 = b2 + kstep;
            if (last && has_next) S.a_ready(nxt);
            if constexpr (SP2) {
            PG8_LDB(B0, 0, 0); PG8_LDB(B1, 0, 1); PG8_SCHED; PG8_LDA(At, 0, 0); PG8_STAGE(PG8_SA(1, 1), a1 + hstep, voffA);
            PG8_WAIT_V(8); PG8_WAIT_L(0); PG8_BAR; PG8_MMA(0, 0, At, B0); PG8_MMA(0, 1, At, B1); PG8_BAR; PG8_SCHED;
            PG8_LDA(At, 0, 1); PG8_STAGE(PG8_SB(0, 0), b2, voffB); PG8_STAGE(PG8_SB(0, 1), b2 + hstep, voffB); PG8_STAGE(PG8_SA(0, 0), a2, voffA);
            PG8_WAIT_V(8); PG8_WAIT_L(0); PG8_BAR; PG8_MMA(1, 0, At, B0); PG8_MMA(1, 1, At, B1); PG8_BAR; PG8_SCHED;
            PG8_LDB(B0, 1, 0); PG8_LDB(B1, 1, 1); PG8_SCHED; PG8_LDA(At, 1, 0); PG8_STAGE(PG8_SA(0, 1), a2 + hstep, voffA);
            PG8_WAIT_V(8); PG8_WAIT_L(0); PG8_BAR; PG8_MMA(0, 0, At, B0); PG8_MMA(0, 1, At, B1); PG8_BAR; PG8_SCHED;
            PG8_LDA(At, 1, 1); PG8_STAGE(PG8_SB(1, 0), b3, voffB); PG8_STAGE(PG8_SB(1, 1), b3 + hstep, voffB); PG8_STAGE(PG8_SA(1, 0), a3, voffA);
            PG8_WAIT_V(8); PG8_WAIT_L(0); PG8_BAR; PG8_MMA(1, 0, At, B0); PG8_MMA(1, 1, At, B1); PG8_BAR; PG8_SCHED;
            } else {
            PG8_LDB(B0, 0, 0); PG8_SCHED; PG8_LDA(At, 0, 0); PG8_STAGE(PG8_SA(1, 1), a1 + hstep, voffA);
            PG8_WAIT_L(8); PG8_BAR; PG8_WAIT_L(0); PG8_MMA(0, 0, At, B0); PG8_BAR; PG8_SCHED;
            PG8_LDB(B1, 0, 1); PG8_STAGE(PG8_SB(0, 0), b2, voffB);
            PG8_BAR; PG8_WAIT_L(0); PG8_MMA(0, 1, At, B1); PG8_BAR;
            PG8_LDA(At, 0, 1); PG8_STAGE(PG8_SA(0, 0), a2, voffA);
            PG8_BAR; PG8_WAIT_L(0); PG8_MMA(1, 0, At, B0); PG8_BAR; PG8_SCHED;
            PG8_STAGE(PG8_SB(0, 1), b2 + hstep, voffB);
            PG8_WAIT_V(6); PG8_BAR; PG8_MMA(1, 1, At, B1); PG8_BAR;
            PG8_LDB(B0, 1, 0); PG8_SCHED; PG8_LDA(At, 1, 0); PG8_STAGE(PG8_SA(0, 1), a2 + hstep, voffA);
            PG8_WAIT_L(8); PG8_BAR; PG8_WAIT_L(0); PG8_MMA(0, 0, At, B0); PG8_BAR; PG8_SCHED;
            PG8_LDB(B1, 1, 1); PG8_STAGE(PG8_SB(1, 0), b3, voffB);
            PG8_BAR; PG8_WAIT_L(0); PG8_MMA(0, 1, At, B1); PG8_BAR;
            PG8_LDA(At, 1, 1); PG8_STAGE(PG8_SA(1, 0), a3, voffA);
            PG8_BAR; PG8_WAIT_L(0); PG8_MMA(1, 0, At, B0); PG8_BAR; PG8_SCHED;
            PG8_STAGE(PG8_SB(1, 1), b3 + hstep, voffB);
            PG8_WAIT_V(6); PG8_BAR; PG8_MMA(1, 1, At, B1); PG8_BAR;
            }
        }
        if constexpr (ALIGN_EPI) { if (wr == 0) PG8_BAR; }
        if constexpr (!Epi::AFTER_DRAIN) { E(acc, cur, wr, wc, fr, fq); S.done(cur); }
        if (!has_next) break;
#pragma unroll
        for (int a = 0; a < 2; ++a)
#pragma unroll
            for (int b = 0; b < 2; ++b)
#pragma unroll
                for (int m = 0; m < 4; ++m)
#pragma unroll
                    for (int n = 0; n < 2; ++n) acc[a][b][m][n] = (f32x4){0.f, 0.f, 0.f, 0.f};
        cur = nxt; cA = nA; cB = nB; ++ui;
        if constexpr (ALIGN_EPI) { if (wr == 1) PG8_BAR; }
    }
    PG8_WAIT_V(0);
    if constexpr (!ALIGN_EPI) { if (wr == 0) PG8_BAR; }
    PG8_BAR;
    if constexpr (Epi::AFTER_DRAIN) { E.fused(acc, cur, wr, wc, fr, fq, lds, wid, lane); S.done(cur); }
#undef PG8_SA
#undef PG8_SB
#undef PG8_STAGE
#undef PG8_LDA
#undef PG8_LDB
#undef PG8_MMA
#undef PG8_WAIT_V
#undef PG8_WAIT_L
#undef PG8_BAR
#undef PG8_SCHED
}
}
namespace att {
typedef unsigned short bf16;
using bf16x8 = __attribute__((ext_vector_type(8))) short;
using s16x4  = __attribute__((ext_vector_type(4))) short;
using f32x16 = __attribute__((ext_vector_type(16))) float;
using f32x4  = __attribute__((ext_vector_type(4))) float;
using u32x4  = __attribute__((ext_vector_type(4))) unsigned;
using u32x2  = __attribute__((ext_vector_type(2))) unsigned;
#define KSWZ(row, colB) ((row) * 256 + ((colB) ^ (((row) & 7) << 4)))
#define SBAR() __builtin_amdgcn_sched_barrier(0)
constexpr int L_K = 0, L_V = 32768, L_WS = 65536, L_TAB = 67584, L_STASH = 69632, L_END = L_STASH + 65536;
constexpr int SM_OSUM = 0, SM_L = 128 * 33 * 4, SM_M = SM_L + 128;
__device__ __forceinline__ int crow(int r, int hi) { return (r & 3) + 8 * (r >> 2) + 4 * hi; }
__device__ __forceinline__ unsigned cvtpk(float lo, float hi) { unsigned r; asm volatile("v_cvt_pk_bf16_f32 %0, %1, %2" : "=v"(r) : "v"(lo), "v"(hi)); return r; }
__device__ __forceinline__ float bf2f(unsigned short h) { return __uint_as_float(((unsigned)h) << 16); }
__device__ __forceinline__ float ex2(float x) { return __builtin_amdgcn_exp2f(x); }
__device__ __forceinline__ float swapmax(float v) { auto rr = __builtin_amdgcn_permlane32_swap(__float_as_uint(v), __float_as_uint(v), false, false); return fmaxf(__uint_as_float(rr[0]), __uint_as_float(rr[1])); }
__device__ __forceinline__ float swapsum(float v) { auto rr = __builtin_amdgcn_permlane32_swap(__float_as_uint(v), __float_as_uint(v), false, false); return __uint_as_float(rr[0]) + __uint_as_float(rr[1]); }
__device__ __forceinline__ int v_st(int k, int c) { const int kk = (k & ~0xC) | ((k & 4) << 1) | ((k & 8) >> 1); return ((kk >> 3) * 4 + (c >> 5)) * 512 + ((kk & 7) * 32 + (c & 31)) * 2; }
__device__ __forceinline__ int v_rd_base(int lane) { return ((lane & 3) << 3) | (((lane >> 2) & 3) << 6) | (((lane >> 4) & 1) << 5) | (((lane >> 5) & 1) << 8); }
constexpr int v_rd_off(int d0, int ks, int half) { return d0 * 512 + ks * 4096 + half * 2048; }
template <int OFF> __device__ __forceinline__ s16x4 tr_read(int vb) { s16x4 r; asm volatile("ds_read_b64_tr_b16 %0, %1 offset:%2" : "=&v"(r) : "v"(vb), "i"(OFF) : "memory"); return r; }
template <int D0> __device__ __forceinline__ void pv_one(f32x16& od, int vb, bf16x8 pa0, bf16x8 pa1, bf16x8 pa2, bf16x8 pa3) {
  const s16x4 l0 = tr_read<v_rd_off(D0, 0, 0)>(vb), h0 = tr_read<v_rd_off(D0, 0, 1)>(vb), l1 = tr_read<v_rd_off(D0, 1, 0)>(vb), h1 = tr_read<v_rd_off(D0, 1, 1)>(vb);
  const s16x4 l2 = tr_read<v_rd_off(D0, 2, 0)>(vb), h2 = tr_read<v_rd_off(D0, 2, 1)>(vb), l3 = tr_read<v_rd_off(D0, 3, 0)>(vb), h3 = tr_read<v_rd_off(D0, 3, 1)>(vb);
  asm volatile("s_waitcnt lgkmcnt(0)" ::: "memory"); SBAR();
#define PK(L, H) (bf16x8){L[0], L[1], L[2], L[3], H[0], H[1], H[2], H[3]}
  od = __builtin_amdgcn_mfma_f32_32x32x16_bf16(pa0, PK(l0, h0), od, 0, 0, 0);
  od = __builtin_amdgcn_mfma_f32_32x32x16_bf16(pa1, PK(l1, h1), od, 0, 0, 0);
  od = __builtin_amdgcn_mfma_f32_32x32x16_bf16(pa2, PK(l2, h2), od, 0, 0, 0);
  od = __builtin_amdgcn_mfma_f32_32x32x16_bf16(pa3, PK(l3, h3), od, 0, 0, 0);
#undef PK
}
#define PK4(P, BASE, OUT) do { unsigned a0 = cvtpk(P[BASE + 0], P[BASE + 1]), a1 = cvtpk(P[BASE + 2], P[BASE + 3]);   \
    unsigned b0 = cvtpk(P[BASE + 4], P[BASE + 5]), b1 = cvtpk(P[BASE + 6], P[BASE + 7]);                              \
    auto r0 = __builtin_amdgcn_permlane32_swap(a0, b0, false, false); auto r1 = __builtin_amdgcn_permlane32_swap(a1, b1, false, false); \
    u32x4 w = {r0[0], r1[0], r0[1], r1[1]}; OUT = *reinterpret_cast<bf16x8*>(&w); } while (0)

template <int DQK, int DV, int MODE>
__device__ __forceinline__ void big_core(char* lds, const bf16* __restrict__ Qw, int ldq, const bf16* __restrict__ Kh, int ldk, const bf16* __restrict__ Vh, int ldv,
                                         int t_lo, int t_hi, int vis_lo, int vis_hi, int qpos_w, float slope2, f32x16 (&o)[DV / 32]) {
  int tid = threadIdx.x; asm volatile("" : "+v"(tid));
  const int wid = __builtin_amdgcn_readfirstlane(tid >> 6), lane = tid & 63, r32 = lane & 31, hi = lane >> 5;
  char* K_lds = lds + L_K; char* V_lds = lds + L_V;
  float* al_l = (float*)(lds + L_WS) + wid * 64; float* li_l = al_l + 32;
  const float* tab = (const float*)(lds + L_TAB);
  constexpr int NQ = DQK / 16, NO = DV / 32, NKL = DQK / 64, NVL = DV / 64, CPRK = DQK / 8, CPRV = DV / 8;
  bf16x8 qr[NQ];
#pragma unroll
  for (int d0 = 0; d0 < NQ; ++d0) qr[d0] = *reinterpret_cast<const bf16x8*>(Qw + (long)r32 * ldq + d0 * 16 + hi * 8);
#pragma unroll
  for (int d = 0; d < NO; ++d) o[d] = f32x16{};
  float m_reg = -1e30f, l_reg = 0.f;
  const int vb0 = (int)(uintptr_t)V_lds + v_rd_base(lane);
  bf16x8 ks_[NKL], vs_[NVL];
#define SLOAD(t) do { _Pragma("unroll") for (int i = 0; i < NKL; ++i) { const int c = tid + 512 * i; ks_[i] = *reinterpret_cast<const bf16x8*>(Kh + (long)((t) * 64 + c / CPRK) * ldk + (c % CPRK) * 8); } \
                      _Pragma("unroll") for (int i = 0; i < NVL; ++i) { const int c = tid + 512 * i; vs_[i] = *reinterpret_cast<const bf16x8*>(Vh + (long)((t) * 64 + c / CPRV) * ldv + (c % CPRV) * 8); } } while (0)
#define SWRITE(b) do { _Pragma("unroll") for (int i = 0; i < NKL; ++i) { const int c = tid + 512 * i; *reinterpret_cast<bf16x8*>(K_lds + (b) * 16384 + KSWZ(c / CPRK, (c % CPRK) * 16)) = ks_[i]; } \
                       _Pragma("unroll") for (int i = 0; i < NVL; ++i) { const int c = tid + 512 * i; *reinterpret_cast<bf16x8*>(V_lds + (b) * 16384 + v_st(c / CPRV, (c % CPRV) * 8)) = vs_[i]; } } while (0)
  SLOAD(t_lo); SWRITE(0); __syncthreads();
  for (int t = t_lo; t < t_hi; ++t) {
    const int cur = (t - t_lo) & 1;
    const bool more = (t + 1 < t_hi);
    if (more) SLOAD(t + 1);
    if (t >= vis_lo && t <= vis_hi) {
      const char* Ks = K_lds + cur * 16384;
      const int rel0 = qpos_w + r32 - t * 64;
      f32x16 p0, p1;
      bool lookup = false;
      if (MODE == 1) { lookup = (qpos_w - (t * 64 + 63)) < 128; const float c = lookup ? 0.f : tab[256];
#pragma unroll
        for (int r = 0; r < 16; ++r) { p0[r] = c; p1[r] = c; } }
      else { p0 = f32x16{}; p1 = f32x16{}; }
#pragma unroll
      for (int d0 = 0; d0 < NQ; ++d0) { const int cb = (d0 * 16 + hi * 8) * 2;
        const bf16x8 b0 = *reinterpret_cast<const bf16x8*>(Ks + KSWZ(r32, cb));
        const bf16x8 b1 = *reinterpret_cast<const bf16x8*>(Ks + KSWZ(32 + r32, cb));
        p0 = __builtin_amdgcn_mfma_f32_32x32x16_bf16(b0, qr[d0], p0, 0, 0, 0);
        p1 = __builtin_amdgcn_mfma_f32_32x32x16_bf16(b1, qr[d0], p1, 0, 0, 0); }
      if (MODE == 1) { if (lookup) {
#pragma unroll
          for (int r = 0; r < 16; ++r) { const int i0 = min(rel0 - crow(r, hi), 128) + 128, i1 = min(rel0 - crow(r, hi) - 32, 128) + 128; p0[r] += tab[i0]; p1[r] += tab[i1]; } } }
      if (MODE == 2) {
#pragma unroll
        for (int r = 0; r < 16; ++r) { const float d0f = (float)(rel0 - crow(r, hi)), d1f = (float)(rel0 - crow(r, hi) - 32); p0[r] -= slope2 * fabsf(d0f); p1[r] -= slope2 * fabsf(d1f); } }
      float pmax = p0[0];
#pragma unroll
      for (int r = 1; r < 16; ++r) pmax = fmaxf(pmax, p0[r]);
#pragma unroll
      for (int r = 0; r < 16; ++r) pmax = fmaxf(pmax, p1[r]);
      pmax = swapmax(pmax);
      const float mn = fmaxf(m_reg, pmax), alpha = ex2(m_reg - mn); m_reg = mn;
      float ps = 0.f;
#pragma unroll
      for (int r = 0; r < 16; ++r) { p0[r] = ex2(p0[r] - mn); p1[r] = ex2(p1[r] - mn); ps += p0[r] + p1[r]; }
      ps = swapsum(ps);
      l_reg = l_reg * alpha + ps;
      bf16x8 pa0, pa1, pa2, pa3;
      PK4(p0, 0, pa0); PK4(p0, 8, pa1); PK4(p1, 0, pa2); PK4(p1, 8, pa3);
      if (__any(alpha < 1.f)) { if (hi == 0) al_l[r32] = alpha; asm volatile("s_waitcnt lgkmcnt(0)" ::: "memory");
#pragma unroll
        for (int d = 0; d < NO; ++d)
#pragma unroll
          for (int r = 0; r < 16; ++r) o[d][r] *= al_l[crow(r, hi)]; }
      const int vb = vb0 + cur * 16384;
      pv_one<0>(o[0], vb, pa0, pa1, pa2, pa3); pv_one<1>(o[1], vb, pa0, pa1, pa2, pa3);
      if constexpr (NO == 4) { pv_one<2>(o[2], vb, pa0, pa1, pa2, pa3); pv_one<3>(o[3], vb, pa0, pa1, pa2, pa3); }
    }
    if (more) SWRITE(cur ^ 1);
    __syncthreads();
  }
#undef SLOAD
#undef SWRITE
  if (hi == 0) li_l[r32] = l_reg; asm volatile("s_waitcnt lgkmcnt(0)" ::: "memory");
#pragma unroll
  for (int r = 0; r < 16; ++r) { const float rl = __builtin_amdgcn_rcpf(li_l[crow(r, hi)]);
#pragma unroll
    for (int d = 0; d < NO; ++d) o[d][r] *= rl; }
}
template <int DV>
__device__ __forceinline__ void store_tile_bf16(char* stg, bf16* Ow, int ldo, const f32x16 (&o)[DV / 32]) {
  int tid_ = threadIdx.x; asm volatile("" : "+v"(tid_));
  const int lane = tid_ & 63, r32 = lane & 31, hi = lane >> 5;
  constexpr int PITCH = DV * 2, CPR = DV / 8;
#pragma unroll
  for (int d = 0; d < DV / 32; ++d)
#pragma unroll
    for (int r = 0; r < 16; ++r) *(unsigned short*)(stg + crow(r, hi) * PITCH + (d * 32 + r32) * 2) = (unsigned short)(cvtpk(o[d][r], 0.f) & 0xffffu);
  asm volatile("s_waitcnt lgkmcnt(0)" ::: "memory");
#pragma unroll
  for (int i = 0; i < (32 * CPR) / 64; ++i) { const int c = i * 64 + lane, row = c / CPR, ch = c % CPR;
    const u32x4 v = *(const u32x4*)(stg + row * PITCH + ch * 16); *(u32x4*)(Ow + (long)row * ldo + ch * 8) = v; }
  asm volatile("s_waitcnt lgkmcnt(0)" ::: "memory");
}

__device__ __forceinline__ const float* uniform_ptr(const float* p) {
  const unsigned long long v = (unsigned long long)p; const unsigned lo = __builtin_amdgcn_readfirstlane((unsigned)v), hi = __builtin_amdgcn_readfirstlane((unsigned)(v >> 32));
  return (const float*)(const __attribute__((address_space(1))) float*)(((unsigned long long)hi << 32) | lo);
}
template <int DQK, int DV, int MODE, int VB>
__device__ __forceinline__ void small_core(char* lds, const bf16* __restrict__ Qp, int ldq, const float* __restrict__ Kc, const float* __restrict__ Vc, int n0,
                                           const float* __restrict__ Kn, const float* __restrict__ Vn, int pitch, int qpos0, int kpos_c, int kpos_n, float slope2) {
  int tid = threadIdx.x; asm volatile("" : "+v"(tid));
  const int wid = __builtin_amdgcn_readfirstlane(tid >> 6), lane = tid & 63, r32 = lane & 31, hi = lane >> 5;
  float* Osum = (float*)(lds + SM_OSUM); float* lsum = (float*)(lds + SM_L); float* mbuf = (float*)(lds + SM_M);
  const float* tab = (const float*)(lds + L_TAB);
  constexpr int NQ = DQK / 16, NO = DV / 32;
  for (int i = tid; i < 128 * 33 + 32; i += 512) Osum[i] = 0.f;
  bf16x8 qr[NQ];
#pragma unroll
  for (int d0 = 0; d0 < NQ; ++d0) qr[d0] = *reinterpret_cast<const bf16x8*>(Qp + (long)r32 * ldq + d0 * 16 + hi * 8);
  f32x16 o[NO];
#pragma unroll
  for (int d = 0; d < NO; ++d) o[d] = f32x16{};
  float m_reg = -1e30f, l_reg = 0.f;
  const int nt0 = n0 / 32, nt = nt0 + (Kn ? 1 : 0);
  for (int t = wid; t < nt; t += 8) {
    const bool isnew = t >= nt0;
    const float* Kp = uniform_ptr(isnew ? Kn : Kc + (long)t * 32 * pitch);
    const float* Vp = uniform_ptr(isnew ? Vn : Vc + (long)t * 32 * pitch);
    const unsigned koffB = (unsigned)(r32 * pitch + hi * 8) * 4u, voffB = (unsigned)(4 * hi * pitch + r32) * 4u;
    const int kbase = isnew ? kpos_n : kpos_c + t * 32;
    const int rel0 = qpos0 + r32 - kbase;
    f32x16 p;
    bool lookup = false;
    if (MODE == 1) { lookup = (qpos0 - (kbase + 31)) < 128; const float c = lookup ? 0.f : tab[256];
#pragma unroll
      for (int r = 0; r < 16; ++r) p[r] = c; }
    else p = f32x16{};
#pragma unroll
    for (int kc = 0; kc < NQ; kc += 4) {
      f32x4 kf[4][2];
#pragma unroll
      for (int d0 = 0; d0 < 4; ++d0) { const char* kp = (const char*)(Kp + (kc + d0) * 16) + koffB; kf[d0][0] = *(const f32x4*)kp; kf[d0][1] = *(const f32x4*)(kp + 16); }
#pragma unroll
      for (int d0 = 0; d0 < 4; ++d0) { u32x4 w = {cvtpk(kf[d0][0][0], kf[d0][0][1]), cvtpk(kf[d0][0][2], kf[d0][0][3]), cvtpk(kf[d0][1][0], kf[d0][1][1]), cvtpk(kf[d0][1][2], kf[d0][1][3])};
        p = __builtin_amdgcn_mfma_f32_32x32x16_bf16(*reinterpret_cast<bf16x8*>(&w), qr[kc + d0], p, 0, 0, 0); }
      asm volatile("" ::: "memory");
    }
    if (MODE == 1) { if (lookup) {
#pragma unroll
        for (int r = 0; r < 16; ++r) p[r] += tab[min(rel0 - crow(r, hi), 128) + 128]; } }
    if (MODE == 2) {
#pragma unroll
      for (int r = 0; r < 16; ++r) p[r] -= slope2 * fabsf((float)(rel0 - crow(r, hi))); }
    float pmax = p[0];
#pragma unroll
    for (int r = 1; r < 16; ++r) pmax = fmaxf(pmax, p[r]);
    pmax = swapmax(pmax);
    const float mn = fmaxf(m_reg, pmax), alpha = ex2(m_reg - mn); m_reg = mn;
    float ps = 0.f;
#pragma unroll
    for (int r = 0; r < 16; ++r) { p[r] = ex2(p[r] - mn); ps += p[r]; }
    ps = swapsum(ps);
    l_reg = l_reg * alpha + ps;
#pragma unroll
    for (int d = 0; d < NO; ++d)
#pragma unroll
      for (int r = 0; r < 16; ++r) o[d][r] *= alpha;
    bf16x8 pb[2];
#pragma unroll
    for (int s = 0; s < 2; ++s) { u32x4 w = {cvtpk(p[8 * s + 0], p[8 * s + 1]), cvtpk(p[8 * s + 2], p[8 * s + 3]), cvtpk(p[8 * s + 4], p[8 * s + 5]), cvtpk(p[8 * s + 6], p[8 * s + 7])}; pb[s] = *reinterpret_cast<bf16x8*>(&w); }
#pragma unroll
    for (int dh = 0; dh < NO; dh += VB) {
      float vf[VB][2][8];
#pragma unroll
      for (int db = 0; db < VB; ++db)
#pragma unroll
        for (int s = 0; s < 2; ++s)
#pragma unroll
          for (int j = 0; j < 8; ++j) vf[db][s][j] = *(const float*)((const char*)(Vp + (long)(16 * s + 8 * (j >> 2) + (j & 3)) * pitch + (dh + db) * 32) + voffB);
#pragma unroll
      for (int db = 0; db < VB; ++db)
#pragma unroll
        for (int s = 0; s < 2; ++s) { u32x4 w = {cvtpk(vf[db][s][0], vf[db][s][1]), cvtpk(vf[db][s][2], vf[db][s][3]), cvtpk(vf[db][s][4], vf[db][s][5]), cvtpk(vf[db][s][6], vf[db][s][7])};
          o[dh + db] = __builtin_amdgcn_mfma_f32_32x32x16_bf16(*reinterpret_cast<bf16x8*>(&w), pb[s], o[dh + db], 0, 0, 0); }
      asm volatile("" ::: "memory");
    }
  }
  if (hi == 0) mbuf[wid * 32 + r32] = m_reg;
  __syncthreads();
  float mx = mbuf[r32];
#pragma unroll
  for (int w = 1; w < 8; ++w) mx = fmaxf(mx, mbuf[w * 32 + r32]);
  const float sc = ex2(m_reg - mx);
  if (hi == 0) atomicAdd(&lsum[r32], l_reg * sc);
#pragma unroll
  for (int d = 0; d < NO; ++d)
#pragma unroll
    for (int r = 0; r < 16; ++r) atomicAdd(&Osum[(d * 32 + crow(r, hi)) * 33 + r32], o[d][r] * sc);
  __syncthreads();
}
#undef SBAR
}
constexpr int NWAVES = 8, NTHREADS = 512;
constexpr int LDSCTL_OFF = 139264, LDS_BYTES = 147456;
constexpr int CW_BAR = 4096;
static_assert(att::L_END <= LDSCTL_OFF && LDSCTL_OFF + 256 <= LDS_BYTES, "LDS map");
#define GAS __attribute__((address_space(1)))
#define LAS __attribute__((address_space(3)))
typedef unsigned short bf16;
typedef unsigned v4u __attribute__((ext_vector_type(4)));
typedef float f32x4 __attribute__((ext_vector_type(4)));
typedef short bf16x8 __attribute__((ext_vector_type(8)));
typedef GAS unsigned gu32;
typedef GAS unsigned long long gu64;
#define RLX_AGENT __ATOMIC_RELAXED, __HIP_MEMORY_SCOPE_AGENT
#define LDS_WAIT() asm volatile("s_waitcnt lgkmcnt(0)" ::: "memory")
#define VM_WAIT() asm volatile("s_waitcnt vmcnt(0)" ::: "memory")
__device__ __forceinline__ unsigned long long rt() { return __builtin_amdgcn_s_memrealtime(); }
__device__ __forceinline__ unsigned f2bf(float f) { unsigned u = __builtin_bit_cast(unsigned, f); return (u + 0x7fffu + ((u >> 16) & 1u)) >> 16; }
__device__ __forceinline__ unsigned pk2(float lo, float hi) { return f2bf(lo) | (f2bf(hi) << 16); }

#define XB_TMO      128
#define XB_XCNT(j)  (256  + 64 * (j))
#define XB_XSUB(j)  (1280 + 64 * (j))
#define XB_XGEN(j)  (2304 + 64 * (j))
#define XB_TOP      3328
#define XB_TOPGEN   3392
#define XCD_BAR_WORDS 3456
#define XB_SPIN_CAP (1u << 18)

__device__ __forceinline__ unsigned xb_ld(unsigned* p)              { return __hip_atomic_load(p, __ATOMIC_RELAXED, __HIP_MEMORY_SCOPE_AGENT); }
__device__ __forceinline__ unsigned xb_add(unsigned* p, unsigned v) { return __hip_atomic_fetch_add(p, v, __ATOMIC_RELAXED, __HIP_MEMORY_SCOPE_AGENT); }
__device__ __forceinline__ unsigned xb_xcc_id() { return (unsigned)__builtin_amdgcn_s_getreg((3 << 11) | 20) & 0xFu; }
#define XB_SPIN(cond, bar) do { unsigned _sp = 0; while (cond) { __builtin_amdgcn_s_sleep(1); \
    if ((++_sp & 255u) == 0u) { if (xb_ld(&(bar)[XB_TMO])) break; if (_sp > XB_SPIN_CAP) { atomicAdd(&(bar)[XB_TMO], 1u); break; } } } } while (0)

struct XcdBarrier {
    unsigned* bar; unsigned x;
    volatile LAS unsigned* st;
};

__device__ __forceinline__ XcdBarrier xcd_barrier_post(unsigned* bar, volatile LAS unsigned* st) {
    XcdBarrier b; b.bar = bar; b.x = xb_xcc_id(); b.st = st;
    if (threadIdx.x == 0) (void)xb_add(&bar[XB_XCNT(b.x)], 1u);
    return b;
}
__device__ __forceinline__ void xcd_barrier_complete(unsigned* bar, unsigned x, unsigned& nloc, unsigned& nx) {
    const unsigned G = gridDim.x * gridDim.y * gridDim.z;
    unsigned sum, cnt, mine, sp = 0u;
    for (;;) {
        sum = 0u; cnt = 0u; mine = 0u;
#pragma unroll
        for (unsigned j = 0; j < 16; ++j) { const unsigned c = xb_ld(&bar[XB_XCNT(j)]); sum += c; cnt += (c > 0u) ? 1u : 0u; mine = (j == x) ? c : mine; }
        if (sum == G) break;
        __builtin_amdgcn_s_sleep(1);
        if ((++sp & 255u) == 0u) { if (xb_ld(&bar[XB_TMO])) break; if (sp > XB_SPIN_CAP) { atomicAdd(&bar[XB_TMO], 1u); break; } }
    }
    nloc = mine > 0u ? mine : 1u; nx = cnt > 0u ? cnt : 1u;
}

__device__ __forceinline__ void xcd_barrier(const XcdBarrier& b) {
    asm volatile("s_waitcnt vmcnt(0)" ::: "memory");
    __syncthreads();
    if (threadIdx.x == 0) {
        unsigned* bar = b.bar;
        __builtin_amdgcn_s_waitcnt(0);
        unsigned nloc = b.st[0], nx = b.st[1];
        if (nloc == 0u) { xcd_barrier_complete(bar, b.x, nloc, nx); b.st[0] = nloc; b.st[1] = nx; }
        const unsigned old = xb_add(&bar[XB_XSUB(b.x)], 1u);
        const unsigned gen = old / nloc;
        if (old + 1u == (gen + 1u) * nloc) {
            __builtin_amdgcn_fence(__ATOMIC_RELEASE, "agent");
            asm volatile("s_waitcnt vmcnt(0)" ::: "memory");
            const unsigned og = xb_add(&bar[XB_TOP], 1u);
            const unsigned tg = og / nx;
            if (og + 1u == (tg + 1u) * nx) xb_add(&bar[XB_TOPGEN], 1u);
            else XB_SPIN(xb_ld(&bar[XB_TOPGEN]) == tg, bar);
            __builtin_amdgcn_fence(__ATOMIC_ACQUIRE, "agent");
            xb_add(&bar[XB_XGEN(b.x)], 1u);
            asm volatile("s_waitcnt vmcnt(0)" ::: "memory");
        } else {
            XB_SPIN(xb_ld(&bar[XB_XGEN(b.x)]) == gen, bar);
            __builtin_amdgcn_fence(__ATOMIC_ACQUIRE, "agent");
            asm volatile("s_waitcnt vmcnt(0)" ::: "memory");
        }
    }
    __syncthreads();
}

struct Args { const float* in[21]; float* out; unsigned char* ws; };
enum { I_XP = 0, I_XS, I_MEM, I_CAK, I_CAV, I_CBK, I_CBV, I_CMK, I_CMV, I_NG, I_WGU, I_WDN, I_WIN, I_RB, I_DL, I_SG, I_WOUT, I_MNG, I_WCQ, I_WCKV, I_WCO };

__device__ __forceinline__ float wave_sum(float v) {
#pragma unroll
    for (int o = 1; o < 64; o <<= 1) v += __shfl_xor(v, o);
    return v;
}
__device__ __forceinline__ void transpose_item(const float* W, int K, int N, int k0, int ns0, bf16* WT, int nd0, LAS float* scr, int lane) {
#pragma unroll 8
    for (int i = 0; i < 32; ++i) { const int kk = 2 * i + (lane >> 5); scr[kk * 33 + (lane & 31)] = W[(size_t)(k0 + kk) * N + ns0 + (lane & 31)]; }
    LDS_WAIT(); asm volatile("" ::: "memory");
    const int c = lane & 7;
#pragma unroll
    for (int j = 0; j < 4; ++j) { const int n = (lane >> 3) + 8 * j; const LAS float* s = scr + (8 * c) * 33 + n;
        v4u o; o.x = pk2(s[0 * 33], s[1 * 33]); o.y = pk2(s[2 * 33], s[3 * 33]); o.z = pk2(s[4 * 33], s[5 * 33]); o.w = pk2(s[6 * 33], s[7 * 33]);
        *(GAS v4u*)(WT + (size_t)(nd0 + n) * K + k0 + 8 * c) = o; }
    LDS_WAIT(); asm volatile("" ::: "memory");
}
__device__ __forceinline__ void norm_row(const float* xrow, const float* g, bf16* orow, int lane) {
    const GAS f32x4* xr = (const GAS f32x4*)xrow + lane; const GAS f32x4* gr = (const GAS f32x4*)g + lane;
    f32x4 v[4]; float s = 0.f;
#pragma unroll
    for (int j = 0; j < 4; ++j) { v[j] = xr[64 * j]; s += (v[j].x * v[j].x + v[j].y * v[j].y) + (v[j].z * v[j].z + v[j].w * v[j].w); }
    const float r = rsqrtf(wave_sum(s) * (1.f / DM) + EPS);
    GAS unsigned long long* o8 = (GAS unsigned long long*)orow + lane;
#pragma unroll
    for (int j = 0; j < 4; ++j) { const f32x4 gg = gr[64 * j];
        o8[64 * j] = (unsigned long long)pk2(v[j].x * r * gg.x, v[j].y * r * gg.y) | ((unsigned long long)pk2(v[j].z * r * gg.z, v[j].w * r * gg.w) << 32); }
}
__device__ __forceinline__ void resid_row(const float* xsrc, const bf16* yrow, float* xdst, bf16* xnrow, const float* gpost, const float* gnext, float w, bool has_next, int lane) {
    const GAS f32x4* xr = (const GAS f32x4*)xsrc + lane; const GAS unsigned long long* yr = (const GAS unsigned long long*)yrow + lane;
    const GAS f32x4* gp = (const GAS f32x4*)gpost + lane;
    f32x4 x[4], y[4]; float s = 0.f;
#pragma unroll
    for (int j = 0; j < 4; ++j) { x[j] = xr[64 * j]; const unsigned long long q = yr[64 * j]; const unsigned lo = (unsigned)q, hi = (unsigned)(q >> 32);
        y[j].x = __uint_as_float(lo << 16); y[j].y = __uint_as_float(lo & 0xffff0000u); y[j].z = __uint_as_float(hi << 16); y[j].w = __uint_as_float(hi & 0xffff0000u);
        s += (y[j].x * y[j].x + y[j].y * y[j].y) + (y[j].z * y[j].z + y[j].w * y[j].w); }
    const float ry = rsqrtf(wave_sum(s) * (1.f / DM) + EPS) * w;
    float s2 = 0.f;
    GAS f32x4* xo = (GAS f32x4*)xdst + lane;
#pragma unroll
    for (int j = 0; j < 4; ++j) { const f32x4 gg = gp[64 * j]; x[j] = x[j] + y[j] * gg * ry; xo[64 * j] = x[j];
        s2 += (x[j].x * x[j].x + x[j].y * x[j].y) + (x[j].z * x[j].z + x[j].w * x[j].w); }
    if (has_next) {
        const float rx = rsqrtf(wave_sum(s2) * (1.f / DM) + EPS);
        const GAS f32x4* gn = (const GAS f32x4*)gnext + lane; GAS unsigned long long* o8 = (GAS unsigned long long*)xnrow + lane;
#pragma unroll
        for (int j = 0; j < 4; ++j) { const f32x4 gg = gn[64 * j];
            o8[64 * j] = (unsigned long long)pk2(x[j].x * rx * gg.x, x[j].y * rx * gg.y) | ((unsigned long long)pk2(x[j].z * rx * gg.z, x[j].w * rx * gg.w) << 32); }
    }
}
#ifndef EN_ALL
#define EN_ALL 1
#endif
#ifndef EN_SDIFF
#define EN_SDIFF EN_ALL
#endif
#ifndef EN_SBAND
#define EN_SBAND EN_ALL
#endif
#ifndef EN_PBAND
#define EN_PBAND EN_ALL
#endif
#ifndef EN_PDIFF
#define EN_PDIFF EN_ALL
#endif
#ifndef EN_SCROSS
#define EN_SCROSS EN_ALL
#endif
#ifndef EN_PCROSS
#define EN_PCROSS EN_ALL
#endif
#ifndef EN_GEMM
#define EN_GEMM EN_ALL
#endif
#ifndef EN_GU1
#define EN_GU1 EN_GEMM
#endif
#ifndef EN_DN1
#define EN_DN1 EN_GEMM
#endif
#ifndef EN_WIN_
#define EN_WIN_ EN_GEMM
#endif
#ifndef EN_WOUT_
#define EN_WOUT_ EN_GEMM
#endif
#ifndef EN_WCQ_
#define EN_WCQ_ EN_GEMM
#endif
#ifndef EN_WCO_
#define EN_WCO_ EN_GEMM
#endif
#ifndef EN_GU2
#define EN_GU2 EN_GEMM
#endif
#ifndef EN_DN2
#define EN_DN2 EN_GEMM
#endif
#ifndef EN_MEMKV
#define EN_MEMKV EN_GEMM
#endif

__device__ __forceinline__ unsigned long long karg_u64(int byte_off) {
    unsigned long long v; const unsigned long long ka = (unsigned long long)__builtin_amdgcn_kernarg_segment_ptr();
    asm volatile("s_load_dwordx2 %0, %1, %2\n\ts_waitcnt lgkmcnt(0)" : "=s"(v) : "s"(ka), "i"(byte_off) : "memory");
    return v;
}
#define INP(i) ((const float*)(const GAS float*)karg_u64(8 * (i)))
#define OUTP() ((float*)(GAS float*)karg_u64(168))
#define WSP() ((unsigned char*)(GAS unsigned char*)karg_u64(176))
#define WGU ((bf16*)(WSP() + WS_WGU))
#define WDN ((bf16*)(WSP() + WS_WDN))
#define WIN ((bf16*)(WSP() + WS_WIN))
#define WOUT ((bf16*)(WSP() + WS_WOUT))
#define WCQ ((bf16*)(WSP() + WS_WCQ))
#define WCKV ((bf16*)(WSP() + WS_WCKV))
#define WCO ((bf16*)(WSP() + WS_WCO))
#define XN ((bf16*)(WSP() + WS_XN))
#define ACT ((bf16*)(WSP() + WS_ACT))
#define Y ((bf16*)(WSP() + WS_Y))
#define QKV ((bf16*)(WSP() + WS_QKV))
#define MIX ((bf16*)(WSP() + WS_MIX))
#define QC ((bf16*)(WSP() + WS_QC))
#define OC ((bf16*)(WSP() + WS_OC))
#define MEMN ((bf16*)(WSP() + WS_MEMN))
#define MKV ((bf16*)(WSP() + WS_MKV))
#define OS ((float*)(WSP() + WS_OS))
#define out OUTP()
static_assert(sizeof(Args) == 184, "kernarg layout");

__global__ void __launch_bounds__(NTHREADS, 2) fwd_kernel(Args args) {
    extern __shared__ __attribute__((aligned(16))) unsigned char lds[];
    LAS unsigned char* ldsl = (LAS unsigned char*)lds;
    char* ldsg = (char*)lds;
#define FRESH_TID() int tid = threadIdx.x; asm volatile("" : "+v"(tid)); const int lane = tid & 63, wave = __builtin_amdgcn_readfirstlane(tid >> 6), gw = vcu * NWAVES + wave; (void)lane; (void)gw
    const int G = gridDim.x, bx = blockIdx.x;
    const int vcu = (G % 8 == 0) ? (bx % 8) * (G / 8) + bx / 8 : bx;
    { FRESH_TID(); for (int u = tid; u < (LDS_BYTES - LDSCTL_OFF) / 4; u += NTHREADS) ((LAS unsigned*)(ldsl + LDSCTL_OFF))[u] = 0u; }
    __syncthreads();
    (void)xcd_barrier_post((unsigned*)(WSP() + WS_CTL) + CW_BAR, (volatile LAS unsigned*)(ldsl + LDSCTL_OFF) + 8);
#define GRID_BAR() do { XcdBarrier b_; b_.bar = (unsigned*)(WSP() + WS_CTL) + CW_BAR; b_.x = xb_xcc_id(); b_.st = (volatile LAS unsigned*)(ldsl + LDSCTL_OFF) + 8; xcd_barrier(b_); } while (0)
    const int NGW = G * NWAVES;

    {
        FRESH_TID();
        LAS float* scr = (LAS float*)(ldsl + wave * 16384);
        constexpr int I_GU = 4 * 2816, I_DN = 4 * 1408, I_IN = 2 * 1536, I_OUT = 2 * 512, I_CQ = 2 * 256, I_CKV = 2 * 512, I_CO = 2 * 256;
        constexpr int NITEMS = I_GU + I_DN + I_IN + I_OUT + I_CQ + I_CKV + I_CO;
        for (int it = gw; it < NITEMS; it += NGW) {
            int r = it;
            if (r < I_GU) { const int mi = r / 2816, rr = r % 2816, kb = rr / 176, nb = rr % 176, nd0 = nb * 32, pn = nd0 >> 8, wi = nd0 & 255, bj = wi >> 7, j0 = wi & 127;
                transpose_item(INP(I_WGU) + (size_t)mi * DM * NGU, DM, NGU, kb * 64, bj * DFF + 128 * pn + j0, WGU + (size_t)mi * NGU * DM, nd0, scr, lane); continue; } r -= I_GU;
            if (r < I_DN) { const int mi = r / 1408, rr = r % 1408, kb = rr / 32, nb = rr % 32;
                transpose_item(INP(I_WDN) + (size_t)mi * DFF * DM, DFF, DM, kb * 64, nb * 32, WDN + (size_t)mi * DM * DFF, nb * 32, scr, lane); continue; } r -= I_DN;
            if (r < I_IN) { const int mi = r / 1536, rr = r % 1536, kb = rr / 96, nb = rr % 96;
                transpose_item(INP(I_WIN) + (size_t)mi * DM * NIN, DM, NIN, kb * 64, nb * 32, WIN + (size_t)mi * NIN * DM, nb * 32, scr, lane); continue; } r -= I_IN;
            if (r < I_OUT) { const int mi = r / 512, rr = r % 512, kb = rr / 32, nb = rr % 32;
                transpose_item(INP(I_WOUT) + (size_t)mi * DM * DM, DM, DM, kb * 64, nb * 32, WOUT + (size_t)mi * DM * DM, nb * 32, scr, lane); continue; } r -= I_OUT;
            if (r < I_CQ) { const int mi = r / 256, rr = r % 256, kb = rr / 16, nb = rr % 16;
                transpose_item(INP(I_WCQ) + (size_t)mi * DM * 512, DM, 512, kb * 64, nb * 32, WCQ + (size_t)mi * 512 * DM, nb * 32, scr, lane); continue; } r -= I_CQ;
            if (r < I_CKV) { const int mi = r / 512, rr = r % 512, kb = rr / 32, nb = rr % 32;
                transpose_item(INP(I_WCKV) + (size_t)mi * DM * DM, DM, DM, kb * 64, nb * 32, WCKV + (size_t)mi * DM * DM, nb * 32, scr, lane); continue; } r -= I_CKV;
            { const int mi = r / 256, rr = r % 256, kb = rr / 32, nb = rr % 32;
                transpose_item(INP(I_WCO) + (size_t)mi * 512 * DM, 512, DM, kb * 64, nb * 32, WCO + (size_t)mi * DM * 512, nb * 32, scr, lane); }
        }
        { const float* const xp_ = INP(I_XP); const float* const xs0_ = INP(I_XS); const float* const g0_ = INP(I_NG); bf16* const xn_ = XN;
          for (int m = gw; m < MTOT; m += NGW) { const float* xr = m < MP ? xp_ + (size_t)m * DM : xs0_ + (size_t)(m - MP) * DM; norm_row(xr, g0_, xn_ + (size_t)m * DM, lane); } }
        { const float* const mem_ = INP(I_MEM); const float* const mg_ = INP(I_MNG); bf16* const mn_ = MEMN;
          for (int m = gw; m < 2 * MMEM; m += NGW) { const int l = m / MMEM, r = m % MMEM; norm_row(mem_ + (size_t)r * DM, mg_ + l * DM, mn_ + (size_t)m * DM, lane); } }
    }
    GRID_BAR();

#define GEMM_STATIC(Aptr, Bptr, Nn, Kk, EpiT, EpiObj) do { pg8::Gemm g_{(const pg8::bf16_t*)(Aptr), (const pg8::bf16_t*)(Bptr), MTOT, (Nn), (Kk)}; pg8::StaticOrder S_; S_.init(MTOT, (Nn), G, bx); \
        pg8::gemm_phase<EpiT, pg8::StaticOrder, true, true>(ldsl, g_, S_, (EpiObj)); } while (0)
#define THIN(XSRC_IS_INPUT, GPOST, GNEXT, WGT, HASNEXT) do { FRESH_TID(); float* const out_ = out; const bf16* const y_ = Y; bf16* const xn_ = XN; \
        const float* const xp_ = INP(I_XP); const float* const xs0_ = INP(I_XS); const float* const gpo_ = (GPOST); const float* const gne_ = (GNEXT); \
        for (int m = gw; m < MTOT; m += NGW) { \
        const float* xs_ = (XSRC_IS_INPUT) ? (m < MP ? xp_ + (size_t)m * DM : xs0_ + (size_t)(m - MP) * DM) : out_ + (size_t)m * DM; \
        resid_row(xs_, y_ + (size_t)m * DM, out_ + (size_t)m * DM, xn_ + (size_t)m * DM, gpo_, gne_, (WGT), (HASNEXT), lane); } } while (0)

    for (int l = 0; l < DEPTH; ++l) {
        const float* ng = INP(I_NG) + (size_t)l * 8 * DM;
        if (EN_GU1) { pg8::EpiSwiGLU E{(pg8::bf16_t*)ACT, DFF}; GEMM_STATIC(XN, WGU + (size_t)(l * 2 + 0) * NGU * DM, NGU, DM, pg8::EpiSwiGLU, E); }
        if (EN_MEMKV && l == 0) {
#pragma unroll
            for (int ml = 0; ml < 2; ++ml) { pg8::Gemm g_{(const pg8::bf16_t*)(MEMN + (size_t)ml * MMEM * DM), (const pg8::bf16_t*)(WCKV + (size_t)ml * DM * DM), MMEM, DM, DM};
                pg8::SubsetOrder S_; S_.init(MMEM / 256, 4, 32, bx - 88 - 32 * ml); pg8::EpiMemKV E{(pg8::bf16_t*)(MKV + (size_t)ml * MMEM * 1024), out, ml};
                pg8::gemm_phase<pg8::EpiMemKV, pg8::SubsetOrder, true, true>(ldsl, g_, S_, E); }
        }
        GRID_BAR();
        if (EN_DN1) { pg8::EpiPlain E{(pg8::bf16_t*)Y, DM, 1.0f}; GEMM_STATIC(ACT, WDN + (size_t)(l * 2 + 0) * DM * DFF, DM, DFF, pg8::EpiPlain, E); }
        GRID_BAR();
        THIN(l == 0, ng + 1 * DM, ng + 2 * DM, 0.5f, true);
        GRID_BAR();
        if (EN_WIN_) { pg8::EpiQKV E{(pg8::bf16_t*)QKV, out, l}; GEMM_STATIC(XN, WIN + (size_t)l * NIN * DM, NIN, DM, pg8::EpiQKV, E); }
        GRID_BAR();
        {
            FRESH_TID();
            if (EN_SDIFF && vcu < SB * 4 * 2) {
                const int b = vcu >> 3, h = (vcu >> 1) & 3, mp = vcu & 1;
                const float slope2 = exp2f(-2.0f * (float)(h + 1)) * LOG2E;
                const float* Kc = INP(I_CBK) + ((size_t)(l * SB + b) * PAST) * 512 + h * 128 + mp * 64;
                const float* Vc = INP(I_CBV) + ((size_t)(l * SB + b) * PAST) * 512 + h * 128;
                const float* Kn = out + O_SBK + ((size_t)l * MS + b * ST) * 512 + h * 128 + mp * 64;
                const float* Vn = out + O_SBV + ((size_t)l * MS + b * ST) * 512 + h * 128;
                att::small_core<64, 128, 2, 2>(ldsg, (const att::bf16*)QKV + (size_t)(MP + b * ST) * NIN + 1536 + h * 128 + mp * 64, NIN, Kc, Vc, PAST, Kn, Vn, 512, PAST, 0, PAST, slope2);
                const float* Osum = (const float*)(ldsg + att::SM_OSUM); const float* lsum = (const float*)(ldsg + att::SM_L);
                float* od = OS + (size_t)mp * MS * 512 + (size_t)(b * ST) * 512 + h * 128;
                for (int i = tid; i < 32 * 128; i += NTHREADS) { const int q = i >> 7, d = i & 127; od[(size_t)q * 512 + d] = Osum[d * 33 + q] / lsum[q]; }
                __syncthreads();
            }
            if (EN_SBAND && vcu < SB * 8) {
                const int b = vcu >> 3, h = vcu & 7;
                if (tid < 257) ((float*)(ldsg + att::L_TAB))[tid] = INP(I_RB)[(size_t)(l * 8 + h) * 257 + tid] * LOG2E;
                __syncthreads();
                const float* Kc = INP(I_CAK) + ((size_t)(l * SB + b) * WA) * 512 + h * 64;
                const float* Vc = INP(I_CAV) + ((size_t)(l * SB + b) * WA) * 512 + h * 64;
                const float* Kn = out + O_SAK + ((size_t)l * MS + b * ST) * 512 + h * 64;
                const float* Vn = out + O_SAV + ((size_t)l * MS + b * ST) * 512 + h * 64;
                att::small_core<64, 64, 1, 2>(ldsg, (const att::bf16*)QKV + (size_t)(MP + b * ST) * NIN + h * 64, NIN, Kc, Vc, WA, Kn, Vn, 512, PAST, PAST - WA, PAST, 0.f);
                const float* Osum = (const float*)(ldsg + att::SM_OSUM); const float* lsum = (const float*)(ldsg + att::SM_L);
                bf16* od = MIX + (size_t)(MP + b * ST) * DM + h * 64;
                for (int i = tid; i < 32 * 64; i += NTHREADS) { const int q = i >> 6, d = i & 63; od[(size_t)q * DM + d] = (bf16)f2bf(Osum[d * 33 + q] / lsum[q]); }
                __syncthreads();
            }
            for (int i = 0; EN_PBAND && i < 4; ++i) {
                const int u = i * G + vcu; if (u >= PB * 8 * 16) break;
                const int bh = u >> 4, qb = u & 15, b = bh >> 3, h = bh & 7, q0 = qb * 256; const size_t rowbase = (size_t)b * PT;
                if (tid < 257) ((float*)(ldsg + att::L_TAB))[tid] = INP(I_RB)[(size_t)(l * 8 + h) * 257 + tid] * LOG2E;
                const int cw = 4 * qb + (wave >> 1);
                att::f32x16 o[2];
                att::big_core<64, 64, 1>(ldsg, (const att::bf16*)QKV + (rowbase + q0 + wave * 32) * NIN + h * 64, NIN, (const att::bf16*)QKV + rowbase * NIN + 512 + h * 64, NIN,
                                         (const att::bf16*)QKV + rowbase * NIN + 1024 + h * 64, NIN, max(0, 4 * qb - 8), 4 * qb + 4, cw - 8, cw, q0 + wave * 32, 0.f, o);
                att::store_tile_bf16<64>(ldsg + wave * 4096, (att::bf16*)MIX + (rowbase + q0 + wave * 32) * DM + h * 64, DM, o);
                __syncthreads();
            }
        }
        GRID_BAR();
        {
            FRESH_TID();
            const float lam_init = 0.8f - 0.6f * expf(-0.3f * (float)l);
            const float* dl = INP(I_DL) + (size_t)l * 256;
            const float lam = expf(wave_sum(dl[lane] * dl[64 + lane])) - expf(wave_sum(dl[128 + lane] * dl[192 + lane])) + lam_init;
            const float* sg = INP(I_SG) + (size_t)l * 128;
            const float gsc = 1.0f - lam_init;
            if (EN_PDIFF && vcu < PB * 4 * 8) {
                const int bh = vcu >> 3, sidx = vcu & 7, b = bh >> 2, h = bh & 3; const size_t rowbase = (size_t)b * PT;
                const float slope2 = exp2f(-2.0f * (float)(h + 1)) * LOG2E;
                const int r32 = lane & 31, hi = lane >> 5;
                for (int half = 0; half < 2; ++half) {
                    const int qb = half == 0 ? sidx : 15 - sidx, q0 = qb * 256, cw = 4 * qb + (wave >> 1);
                    unsigned short* stash = (unsigned short*)(ldsg + att::L_STASH + wave * 8192);
                    att::f32x16 o[4];
                    for (int mp = 0; mp < 2; ++mp) {
                        att::big_core<64, 128, 2>(ldsg, (const att::bf16*)QKV + (rowbase + q0 + wave * 32) * NIN + 1536 + h * 128 + mp * 64, NIN,
                                                  (const att::bf16*)QKV + rowbase * NIN + 2048 + h * 128 + mp * 64, NIN, (const att::bf16*)QKV + rowbase * NIN + 2560 + h * 128, NIN,
                                                  0, 4 * qb + 4, 0, cw, q0 + wave * 32, slope2, o);
                        if (mp == 0) {
#pragma unroll
                            for (int d = 0; d < 4; ++d)
#pragma unroll
                                for (int r = 0; r < 16; ++r) stash[(d * 16 + r) * 64 + lane] = (unsigned short)(att::cvtpk(o[d][r], 0.f) & 0xffffu);
                        }
                    }
                    asm volatile("s_waitcnt lgkmcnt(0)" ::: "memory");
#pragma unroll
                    for (int r = 0; r < 16; ++r) { float ss = 0.f;
#pragma unroll
                        for (int d = 0; d < 4; ++d) { const float v = att::bf2f(stash[(d * 16 + r) * 64 + lane]) - lam * o[d][r]; o[d][r] = v; ss += v * v; }
                        ss += __shfl_xor(ss, 1); ss += __shfl_xor(ss, 2); ss += __shfl_xor(ss, 4); ss += __shfl_xor(ss, 8); ss += __shfl_xor(ss, 16);
                        const float rs = rsqrtf(ss * (1.f / 128.f) + EPS) * gsc;
#pragma unroll
                        for (int d = 0; d < 4; ++d) o[d][r] *= rs; }
#pragma unroll
                    for (int d = 0; d < 4; ++d) { const float gg = sg[d * 32 + r32];
#pragma unroll
                        for (int r = 0; r < 16; ++r) o[d][r] *= gg; }
                    (void)hi;
                    att::store_tile_bf16<128>(ldsg + wave * 8192, (att::bf16*)MIX + (rowbase + q0 + wave * 32) * DM + 512 + h * 128, DM, o);
                    __syncthreads();
                }
            }
            const float* const os_ = OS; bf16* const mix_ = MIX;
            for (int it = gw; it < MS * 4; it += NGW) {
                const int row = it >> 2, h = it & 3; const size_t off = (size_t)row * 512 + h * 128 + 2 * lane;
                const float2 a = *(const float2*)(os_ + off), c = *(const float2*)(os_ + (size_t)MS * 512 + off);
                const float v0 = a.x - lam * c.x, v1 = a.y - lam * c.y;
                const float rs = rsqrtf(wave_sum(v0 * v0 + v1 * v1) * (1.f / 128.f) + EPS) * gsc;
                *(unsigned*)(mix_ + (size_t)(MP + row) * DM + 512 + h * 128 + 2 * lane) = pk2(v0 * rs * sg[2 * lane], v1 * rs * sg[2 * lane + 1]);
            }
        }
        GRID_BAR();
        if (EN_WOUT_) { pg8::EpiPlain E{(pg8::bf16_t*)Y, DM, 1.0f}; GEMM_STATIC(MIX, WOUT + (size_t)l * DM * DM, DM, DM, pg8::EpiPlain, E); }
        GRID_BAR();
        THIN(false, ng + 3 * DM, ng + 4 * DM, 1.0f, true);
        GRID_BAR();
        if (EN_WCQ_) { pg8::EpiPlain E{(pg8::bf16_t*)QC, 512, QS128}; GEMM_STATIC(XN, WCQ + (size_t)l * 512 * DM, 512, DM, pg8::EpiPlain, E); }
        GRID_BAR();
        {
            FRESH_TID();
            if (EN_SCROSS && vcu < SB * 4) {
                const int b = vcu >> 2, h = vcu & 3;
                const float* Kc = INP(I_CMK) + ((size_t)(l * SB + b) * NMEM) * 512 + h * 128;
                const float* Vc = INP(I_CMV) + ((size_t)(l * SB + b) * NMEM) * 512 + h * 128;
                att::small_core<128, 128, 0, 1>(ldsg, (const att::bf16*)QC + (size_t)(MP + b * ST) * 512 + h * 128, 512, Kc, Vc, NMEM, nullptr, nullptr, 512, 0, 0, 0, 0.f);
                const float* Osum = (const float*)(ldsg + att::SM_OSUM); const float* lsum = (const float*)(ldsg + att::SM_L);
                bf16* od = OC + (size_t)(MP + b * ST) * 512 + h * 128;
                for (int i = tid; i < 32 * 128; i += NTHREADS) { const int q = i >> 7, d = i & 127; od[(size_t)q * 512 + d] = (bf16)f2bf(Osum[d * 33 + q] / lsum[q]); }
                __syncthreads();
            }
            for (int i = 0; EN_PCROSS && i < 2; ++i) {
                const int u = i * G + vcu; if (u >= PB * 4 * 16) break;
                const int bh = u >> 4, qb = u & 15, b = bh >> 2, h = bh & 3, q0 = qb * 256; const size_t rowbase = (size_t)b * PT;
                const att::bf16* Kh = (const att::bf16*)MKV + ((size_t)l * MMEM + (size_t)b * NMEM) * 1024 + h * 128;
                att::f32x16 o[4];
                att::big_core<128, 128, 0>(ldsg, (const att::bf16*)QC + (rowbase + q0 + wave * 32) * 512 + h * 128, 512, Kh, 1024, Kh + 512, 1024, 0, 4, 0, 3, 0, 0.f, o);
                att::store_tile_bf16<128>(ldsg + wave * 8192, (att::bf16*)OC + (rowbase + q0 + wave * 32) * 512 + h * 128, 512, o);
                __syncthreads();
            }
        }
        GRID_BAR();
        if (EN_WCO_) { pg8::EpiPlain E{(pg8::bf16_t*)Y, DM, 1.0f}; GEMM_STATIC(OC, WCO + (size_t)l * DM * 512, DM, 512, pg8::EpiPlain, E); }
        GRID_BAR();
        THIN(false, ng + 5 * DM, ng + 6 * DM, 1.0f, true);
        GRID_BAR();
        if (EN_GU2) { pg8::EpiSwiGLU E{(pg8::bf16_t*)ACT, DFF}; GEMM_STATIC(XN, WGU + (size_t)(l * 2 + 1) * NGU * DM, NGU, DM, pg8::EpiSwiGLU, E); }
        GRID_BAR();
        if (EN_DN2) { pg8::EpiPlain E{(pg8::bf16_t*)Y, DM, 1.0f}; GEMM_STATIC(ACT, WDN + (size_t)(l * 2 + 1) * DM * DFF, DM, DFF, pg8::EpiPlain, E); }
        GRID_BAR();
        THIN(false, ng + 7 * DM, INP(I_NG) + (size_t)((l + 1) % DEPTH) * 8 * DM, 0.5f, l + 1 < DEPTH);
        if (l + 1 < DEPTH) GRID_BAR();
    }
}

#undef out
#undef Y
extern "C" void kernel_launch(void* const* d_in, const int* in_sizes, int n_in, void* d_out, int out_size, void* d_ws, size_t ws_size, hipStream_t stream) {
    static int ready = 0;
    if (ready == 0) {
        if (n_in != 21 || (size_t)out_size != O_END || ws_size < WS_END) { fprintf(stderr, "kernel_launch: unexpected shapes: n_in %d out %d ws %zu\n", n_in, out_size, ws_size); ready = -1; return; }
        if (hipFuncSetAttribute((const void*)fwd_kernel, hipFuncAttributeMaxDynamicSharedMemorySize, LDS_BYTES) != hipSuccess) { fprintf(stderr, "kernel_launch: hipFuncSetAttribute failed\n"); ready = -1; return; }
        int per_cu = 0;
        if (hipOccupancyMaxActiveBlocksPerMultiprocessor(&per_cu, (const void*)fwd_kernel, NTHREADS, LDS_BYTES) != hipSuccess || per_cu < 1)
            fprintf(stderr, "kernel_launch: note: occupancy query reports %d workgroups per CU\n", per_cu);
        (void)hipGetLastError();
        ready = 1;
    }
    if (ready < 0) return;
    (void)hipMemsetAsync((char*)d_ws + WS_CTL, 0, CTL_ZERO_BYTES, stream);
    Args a{};
    for (int i = 0; i < 21; ++i) a.in[i] = (const float*)d_in[i];
    a.out = (float*)d_out; a.ws = (unsigned char*)d_ws;
    hipLaunchKernelGGL(fwd_kernel, dim3(256), dim3(NTHREADS), LDS_BYTES, stream, a);
    const hipError_t le = hipPeekAtLastError();
    if (le != hipSuccess) fprintf(stderr, "kernel_launch: launch failed: %s\n", hipGetErrorName(le));
}
```

```cpp
#include <hip/hip_runtime.h>
#include <cstdio>
#include <cstdint>

constexpr int DM = 1024, PB = 8, PT = 4096, SB = 32, ST = 32, DEPTH = 2;
constexpr int MP = PB * PT, MS = SB * ST, MTOT = MP + MS;
constexpr int DFF = 2816, NGU = 2 * DFF, NIN = 3072, NMEM = 256, MMEM = PB * NMEM, PAST = 4096, WA = 512;
constexpr float EPS = 1e-6f, LOG2E = 1.4426950408889634f;
constexpr float QS64 = 0.125f * LOG2E, QS128 = 0.08838834764831845f * LOG2E;
constexpr size_t O_Y = 0, O_PAK = (size_t)MTOT * DM, O_PAV = O_PAK + 4194304, O_PBK = O_PAV + 4194304, O_PBV = O_PBK + 33554432,
                 O_PMK = O_PBV + 33554432, O_PMV = O_PMK + 2097152, O_SAK = O_PMV + 2097152, O_SAV = O_SAK + 1048576,
                 O_SBK = O_SAV + 1048576, O_SBV = O_SBK + 1048576, O_END = O_SBV + 1048576;
static_assert(O_END == 118489088, "output size");
constexpr size_t MiB = 1u << 20;
constexpr size_t WS_CTL = 0, CTL_ZERO_BYTES = MiB;
constexpr size_t WS_WGU = 1 * MiB, WS_WDN = 45 * MiB, WS_WIN = 67 * MiB, WS_WOUT = 79 * MiB, WS_WCQ = 83 * MiB, WS_WCKV = 85 * MiB, WS_WCO = 89 * MiB;
constexpr size_t WS_XN = 92 * MiB, WS_ACT = 158 * MiB, WS_Y = 340 * MiB, WS_QKV = 406 * MiB, WS_MIX = 604 * MiB, WS_QC = 670 * MiB, WS_OC = 703 * MiB;
constexpr size_t WS_MEMN = 736 * MiB, WS_MKV = 744 * MiB, WS_OS = 752 * MiB, WS_RS = 756 * MiB, WS_YP = 757 * MiB, WS_END = 801 * MiB;
static_assert((size_t)MTOT * DFF * 2 <= WS_Y - WS_ACT && (size_t)MTOT * NIN * 2 <= WS_MIX - WS_QKV && (size_t)MTOT * DM * 2 <= WS_ACT - WS_XN, "ws map");
namespace pg8 {
#define PG8_LAS __attribute__((address_space(3)))
typedef unsigned short bf16_t;
typedef short bf16x8 __attribute__((ext_vector_type(8)));
typedef float f32x4 __attribute__((ext_vector_type(4)));
typedef unsigned u32x4 __attribute__((ext_vector_type(4)));
constexpr int BM = 256, BK = 64, HALF = 128, HTB = HALF * BK * 2  , STAGE_BYTES = 8 * HTB, NXCD = 8, WGM = 8;

__host__ __device__ __forceinline__ int lds_byte(int r, int c) { const int st = (r >> 4) * 2 + (c >> 5), rr = r & 15, cc = c & 31, ob = rr * 64 + cc * 2; return st * 1024 + (ob ^ (((ob >> 9) & 1) << 5)); }
__host__ __device__ __forceinline__ void stage_rc(int b, int& R, int& C) { const int st = b / 1024, sb = b % 1024, swz = sb ^ (((sb >> 9) & 1) << 5); R = (st >> 1) * 16 + swz / 64; C = (st & 1) * 32 + (swz % 64) / 2; }
__host__ __device__ __forceinline__ int perm32(int rho) { const int n = rho >> 4, i = rho & 15; return 8 * (i >> 2) + 4 * n + (i & 3); }

struct Unit { int pm, pn, pk; };
struct Gemm { const bf16_t* A; const bf16_t* Bt; int M, N, K, Kc; };

struct StaticOrder {
    int nM, nN, nwg, G, c;
    __host__ __device__ void init(int M, int N, int G_, int c_) { nM = M / BM; nN = N / BM; nwg = nM * nN; G = G_; c = c_; }
    __host__ __device__ bool next(int i, Unit& u) const {
        const long L = (long)i * G + c; if (L >= nwg) return false;
        int wgid = (int)L; { const int q = nwg / NXCD, r = nwg % NXCD, xcd = wgid % NXCD, off = wgid / NXCD; wgid = (xcd < r ? xcd * (q + 1) : r * (q + 1) + (xcd - r) * q) + off; }
        const int nig = WGM * nN, gid = wgid / nig, fm = gid * WGM, gsz = (nM - fm) < WGM ? (nM - fm) : WGM;
        u.pm = fm + ((wgid % nig) % gsz); u.pn = (wgid % nig) / gsz; u.pk = 0; return true;
    }
    __device__ __forceinline__ void a_ready(const Unit&) const {}
    __device__ __forceinline__ void done(const Unit&) const {}
};

typedef float f32x2_cv __attribute__((ext_vector_type(2))); typedef __bf16 bf16x2_cv __attribute__((ext_vector_type(2)));
__device__ __forceinline__ unsigned cvt_pk_bf16(float lo, float hi) { const f32x2_cv v = {lo, hi}; const bf16x2_cv b = __builtin_convertvector(v, bf16x2_cv); return __builtin_bit_cast(unsigned, b); }
typedef float f32x2 __attribute__((ext_vector_type(2)));

struct SubsetOrder {
    int nN, nwg, G, c;
    __device__ __forceinline__ void init(int nM_, int nN_, int G_, int c_) { nN = nN_; nwg = nM_ * nN_; G = G_; c = c_; }
    __device__ __forceinline__ bool next(int i, Unit& u) const {
        if (c < 0 || c >= G) return false;
        const long L = (long)i * G + c; if (L >= nwg) return false;
        u.pm = (int)L / nN; u.pn = (int)L % nN; u.pk = 0; return true;
    }
    __device__ __forceinline__ void a_ready(const Unit&) const {}
    __device__ __forceinline__ void done(const Unit&) const {}
};

struct SplitOrder {
    int nN, SK, nwg, G, c, pm0;
    __device__ __forceinline__ void init(int pm0_, int nM_, int nN_, int SK_, int G_, int c_) { pm0 = pm0_; nN = nN_; SK = SK_; nwg = nM_ * nN_ * SK_; G = G_; c = c_; }
    __device__ __forceinline__ bool next(int i, Unit& u) const {
        const long L = (long)i * G + c; if (L >= nwg) return false;
        u.pk = (int)L % SK; const int t = (int)L / SK; u.pn = t % nN; u.pm = pm0 + t / nN; return true;
    }
    __device__ __forceinline__ void a_ready(const Unit&) const {}
    __device__ __forceinline__ void done(const Unit&) const {}
};
__device__ __forceinline__ u32x4 pack8(f32x4 v0, f32x4 v1) { u32x4 w; w.x = cvt_pk_bf16(v0[0], v0[1]); w.y = cvt_pk_bf16(v0[2], v0[3]); w.z = cvt_pk_bf16(v1[0], v1[1]); w.w = cvt_pk_bf16(v1[2], v1[3]); return w; }
struct EpiPlain {
    static constexpr bool PERM = true, AFTER_DRAIN = false;
    bf16_t* O; int ldo; float scale; const float* rs;
    __device__ __forceinline__ void operator()(const f32x4 (&acc)[2][2][4][2], const Unit& u, int wr, int wc, int fr, int fq) const {
        const bf16_t* base = O + (size_t)u.pm * BM * ldo + (size_t)u.pn * BM;
        const unsigned offB = (unsigned)((wr * 64 + fr) * ldo + wc * 32 + 8 * fq) * 2u, roff = (unsigned)(wr * 64 + fr) * 4u;
        float scv[2][4];
        if (rs) { const float* rsb = rs + (size_t)u.pm * BM;
#pragma unroll
            for (int ai = 0; ai < 2; ++ai)
#pragma unroll
                for (int m = 0; m < 4; ++m) scv[ai][m] = *(const float*)((const char*)(rsb + ai * HALF + m * 16) + roff);
#pragma unroll
            for (int ai = 0; ai < 2; ++ai)
#pragma unroll
                for (int m = 0; m < 4; ++m) scv[ai][m] *= scale; }
        else {
#pragma unroll
            for (int ai = 0; ai < 2; ++ai)
#pragma unroll
                for (int m = 0; m < 4; ++m) scv[ai][m] = scale; }
#pragma unroll
        for (int ai = 0; ai < 2; ++ai)
#pragma unroll
            for (int m = 0; m < 4; ++m) { char* rowp = (char*)(base + (size_t)(ai * HALF + m * 16) * ldo) + offB;
                const float sc = scv[ai][m];
#pragma unroll
                for (int bj = 0; bj < 2; ++bj) *(u32x4*)(rowp + bj * HALF * 2) = pack8(acc[ai][bj][m][0] * sc, acc[ai][bj][m][1] * sc); }
    }
};
__device__ __forceinline__ float silu_mul(float g, float u) { return g * __builtin_amdgcn_rcpf(1.0f + __builtin_amdgcn_exp2f(-1.4426950408889634f * g)) * u; }
struct EpiPartial {
    static constexpr bool PERM = true, AFTER_DRAIN = false;
    float* P; int ldp, row_base; size_t slab;
    __device__ __forceinline__ void operator()(const f32x4 (&acc)[2][2][4][2], const Unit& u, int wr, int wc, int fr, int fq) const {
        const float* base = P + (size_t)u.pk * slab + ((size_t)(u.pm * BM - row_base) * ldp + (size_t)u.pn * BM);
        const unsigned offB = (unsigned)((wr * 64 + fr) * ldp + wc * 32 + 8 * fq) * 4u;
#pragma unroll
        for (int ai = 0; ai < 2; ++ai)
#pragma unroll
            for (int m = 0; m < 4; ++m) { char* rowp = (char*)(base + (size_t)(ai * HALF + m * 16) * ldp) + offB;
#pragma unroll
                for (int bj = 0; bj < 2; ++bj) { *(f32x4*)(rowp + bj * HALF * 4) = acc[ai][bj][m][0]; *(f32x4*)(rowp + bj * HALF * 4 + 16) = acc[ai][bj][m][1]; } }
    }
};
struct EpiSwiGLU {
    static constexpr bool PERM = true, AFTER_DRAIN = false;
    bf16_t* O; int ldo; const float* rs;
    __device__ __forceinline__ void operator()(const f32x4 (&acc)[2][2][4][2], const Unit& u, int wr, int wc, int fr, int fq) const {
        const bf16_t* base = O + (size_t)u.pm * BM * ldo + (size_t)u.pn * HALF;
        const unsigned offB = (unsigned)((wr * 64 + fr) * ldo + wc * 32 + 8 * fq) * 2u, roff = (unsigned)(wr * 64 + fr) * 4u;
        const float* rsb = rs + (size_t)u.pm * BM;
        float scv[2][4];
#pragma unroll
        for (int ai = 0; ai < 2; ++ai)
#pragma unroll
            for (int m = 0; m < 4; ++m) scv[ai][m] = *(const float*)((const char*)(rsb + ai * HALF + m * 16) + roff);
        asm volatile("" : "+v"(scv[0][0]), "+v"(scv[0][1]), "+v"(scv[0][2]), "+v"(scv[0][3]), "+v"(scv[1][0]), "+v"(scv[1][1]), "+v"(scv[1][2]), "+v"(scv[1][3]));
#pragma unroll
        for (int ai = 0; ai < 2; ++ai)
#pragma unroll
            for (int m = 0; m < 4; ++m) { char* rowp = (char*)(base + (size_t)(ai * HALF + m * 16) * ldo) + offB;
                const float sc = scv[ai][m];
                f32x4 a0, a1;
#pragma unroll
                for (int e = 0; e < 4; ++e) { a0[e] = silu_mul(acc[ai][0][m][0][e] * sc, acc[ai][1][m][0][e] * sc); a1[e] = silu_mul(acc[ai][0][m][1][e] * sc, acc[ai][1][m][1][e] * sc); }
                *(u32x4*)rowp = pack8(a0, a1); }
    }
};
struct EpiQKV {
    static constexpr bool PERM = true, AFTER_DRAIN = false;
    bf16_t* QKV; float* out; int layer; const float* rs;
    __device__ __forceinline__ void operator()(const f32x4 (&acc)[2][2][4][2], const Unit& u, int wr, int wc, int fr, int fq) const {
        const int seg = u.pn >> 1, hf = u.pn & 1;
        const float scale = (seg == 0 || seg == 3) ? QS64 : 1.0f;
        const int rl0 = wr * 64 + fr;
        const int colq = u.pn * BM + wc * 32 + 8 * fq, cs = hf * BM + wc * 32 + 8 * fq;
        float* sbase = nullptr;
        const bool nt_state = u.pm < MP / BM;
        if (seg == 1 || seg == 2 || seg == 4 || seg == 5) {
            if (u.pm < MP / BM) {
                if (seg >= 4) sbase = out + (seg == 4 ? O_PBK : O_PBV) + ((size_t)layer * MP + (size_t)u.pm * BM) * 512;
                else if ((u.pm & 15) >= 14) sbase = out + (seg == 1 ? O_PAK : O_PAV) + ((size_t)(layer * PB + (u.pm >> 4)) * WA + (size_t)((u.pm & 15) - 14) * BM) * 512;
            } else {
                const size_t o = seg == 1 ? O_SAK : seg == 2 ? O_SAV : seg == 4 ? O_SBK : O_SBV;
                sbase = out + o + ((size_t)layer * MS + (size_t)(u.pm - MP / BM) * BM) * 512;
            }
        }
        const bf16_t* qbase = QKV + (size_t)u.pm * BM * NIN + (size_t)u.pn * BM;
        const unsigned offB = (unsigned)(rl0 * NIN + wc * 32 + 8 * fq) * 2u, roff = (unsigned)rl0 * 4u;
        const float* rsb = rs + (size_t)u.pm * BM;
        float scv[2][4];
#pragma unroll
        for (int ai = 0; ai < 2; ++ai)
#pragma unroll
            for (int m = 0; m < 4; ++m) scv[ai][m] = *(const float*)((const char*)(rsb + ai * HALF + m * 16) + roff);
#pragma unroll
        for (int ai = 0; ai < 2; ++ai)
#pragma unroll
            for (int m = 0; m < 4; ++m) { char* rowp = (char*)(qbase + (size_t)(ai * HALF + m * 16) * NIN) + offB; const float sc = scv[ai][m] * scale;
#pragma unroll
                for (int bj = 0; bj < 2; ++bj) *(u32x4*)(rowp + bj * HALF * 2) = pack8(acc[ai][bj][m][0] * sc, acc[ai][bj][m][1] * sc); }
        if (sbase) {
            const unsigned soffB = (unsigned)(rl0 * 512 + cs) * 4u;
#pragma unroll
            for (int ai = 0; ai < 2; ++ai)
#pragma unroll
                for (int m = 0; m < 4; ++m) { char* sp = (char*)(sbase + (size_t)(ai * HALF + m * 16) * 512) + soffB; const float sc = scv[ai][m];
#pragma unroll
                    for (int bj = 0; bj < 2; ++bj) { const f32x4 s0_ = acc[ai][bj][m][0] * sc, s1_ = acc[ai][bj][m][1] * sc;
                        if (nt_state) { __builtin_nontemporal_store(s0_, (f32x4*)(sp + bj * HALF * 4)); __builtin_nontemporal_store(s1_, (f32x4*)(sp + bj * HALF * 4 + 16)); }
                        else { *(f32x4*)(sp + bj * HALF * 4) = s0_; *(f32x4*)(sp + bj * HALF * 4 + 16) = s1_; } } }
        }
    }
};
struct EpiMemKV {
    static constexpr bool PERM = true, AFTER_DRAIN = false;
    bf16_t* MKV; float* out; int layer;
    __device__ __forceinline__ void operator()(const f32x4 (&acc)[2][2][4][2], const Unit& u, int wr, int wc, int fr, int fq) const {
        const int row0 = u.pm * BM + wr * 64 + fr, col0 = u.pn * BM + wc * 32 + 8 * fq, cs = (u.pn & 1) * BM + wc * 32 + 8 * fq;
        float* sbase = out + (u.pn < 2 ? O_PMK : O_PMV) + (size_t)layer * MMEM * 512;
#pragma unroll
        for (int ai = 0; ai < 2; ++ai)
#pragma unroll
            for (int m = 0; m < 4; ++m) { const int row = row0 + ai * HALF + m * 16; bf16_t* rowp = MKV + (size_t)row * 1024 + col0;
#pragma unroll
                for (int bj = 0; bj < 2; ++bj) { *(u32x4*)(rowp + bj * HALF) = pack8(acc[ai][bj][m][0], acc[ai][bj][m][1]);
                    float* sp = sbase + (size_t)row * 512 + cs + bj * HALF; *(f32x4*)sp = acc[ai][bj][m][0]; *(f32x4*)(sp + 4) = acc[ai][bj][m][1]; } }
    }
};
template <class Epi, class Sched, bool ALIGN_EPI = false, bool SP2 = false>
__device__ __forceinline__ void gemm_phase(PG8_LAS unsigned char* lds, const Gemm g, const Sched& S, const Epi& E) {
    int tid = threadIdx.x; asm volatile("" : "+v"(tid));
    const int wid = __builtin_amdgcn_readfirstlane(tid >> 6), lane = tid & 63, wr = wid >> 2, wc = wid & 3, fr = lane & 15, fq = lane >> 4;
    const int K = g.K, KL = g.Kc ? g.Kc : g.K, nt = KL / BK;
    unsigned voffA[2], voffB[2];
#pragma unroll
    for (int i = 0; i < 2; ++i) { int R, C; stage_rc(tid * 16 + i * 8192, R, C); const int Rb = Epi::PERM ? ((R & ~31) + perm32(R & 31)) : R;
        voffA[i] = (unsigned)(R * K + C) * 2u; voffB[i] = (unsigned)(Rb * K + C) * 2u; }
    const size_t kstep = (size_t)(BK * 2);
    const size_t hstep = (size_t)HALF * K * 2;
    const size_t tstep = 2 * hstep;
    const unsigned ldsw = (unsigned)wid * 1024u;
    const int aoff = lds_byte(wr * 64 + fr, fq * 8), boff = lds_byte(wc * 32 + fr, fq * 8);
#define PG8_SA(b, h) (((b) * 2 + (h)) * HTB)
#define PG8_SB(b, h) ((4 + (b) * 2 + (h)) * HTB)
#define PG8_STAGE(bufoff, gbase, voff) do { _Pragma("unroll") for (int _i = 0; _i < 2; ++_i) \
        __builtin_amdgcn_global_load_lds((const unsigned*)((const char*)(gbase) + (voff)[_i]), (PG8_LAS unsigned*)(lds + (bufoff) + ldsw + _i * 8192), 16, 0, 0); } while (0)
#define PG8_LDA(dst, b, h) do { _Pragma("unroll") for (int m = 0; m < 4; ++m) _Pragma("unroll") for (int k = 0; k < 2; ++k) dst[m][k] = *(const PG8_LAS bf16x8*)(lds + PG8_SA(b, h) + aoff + m * 2048 + k * 1024); } while (0)
#define PG8_LDB(dst, b, h) do { _Pragma("unroll") for (int n = 0; n < 2; ++n) _Pragma("unroll") for (int k = 0; k < 2; ++k) dst[n][k] = *(const PG8_LAS bf16x8*)(lds + PG8_SB(b, h) + boff + n * 2048 + k * 1024); } while (0)
#define PG8_MMA(ai, bj, At, Bt) do { __builtin_amdgcn_s_setprio(1); _Pragma("unroll") for (int m = 0; m < 4; ++m) _Pragma("unroll") for (int n = 0; n < 2; ++n) _Pragma("unroll") for (int k = 0; k < 2; ++k) \
        acc[ai][bj][m][n] = __builtin_amdgcn_mfma_f32_16x16x32_bf16(Bt[n][k], At[m][k], acc[ai][bj][m][n], 0, 0, 0); __builtin_amdgcn_s_setprio(0); } while (0)
#define PG8_WAIT_V(n) asm volatile("s_waitcnt vmcnt(" #n ")" ::: "memory")
#define PG8_WAIT_L(n) asm volatile("s_waitcnt lgkmcnt(" #n ")" ::: "memory")
#define PG8_BAR __builtin_amdgcn_s_barrier()
#define PG8_SCHED __builtin_amdgcn_sched_barrier(0)
    Unit cur, nxt; int ui = 0;
    if (!S.next(0, cur)) return;
    f32x4 acc[2][2][4][2];
#pragma unroll
    for (int a = 0; a < 2; ++a)
#pragma unroll
        for (int b = 0; b < 2; ++b)
#pragma unroll
            for (int m = 0; m < 4; ++m)
#pragma unroll
                for (int n = 0; n < 2; ++n) acc[a][b][m][n] = (f32x4){0.f, 0.f, 0.f, 0.f};
    bf16x8 At[4][2], B0[2][2], B1[2][2];
    const char* cA = (const char*)g.A + (size_t)cur.pm * tstep + (size_t)cur.pk * KL * 2; const char* cB = (const char*)g.Bt + (size_t)cur.pn * tstep + (size_t)cur.pk * KL * 2;
    S.a_ready(cur);
    if constexpr (SP2) {
        PG8_STAGE(PG8_SB(0, 0), cB, voffB); PG8_STAGE(PG8_SB(0, 1), cB + hstep, voffB); PG8_STAGE(PG8_SA(0, 0), cA, voffA); PG8_STAGE(PG8_SA(0, 1), cA + hstep, voffA);
        if (wr == 1) PG8_BAR;
        PG8_WAIT_V(2); PG8_BAR;
        PG8_STAGE(PG8_SB(1, 0), cB + kstep, voffB); PG8_STAGE(PG8_SA(1, 0), cA + kstep, voffA); PG8_STAGE(PG8_SB(1, 1), cB + hstep + kstep, voffB);
        PG8_WAIT_V(6); PG8_BAR;
    } else {
        PG8_STAGE(PG8_SB(0, 0), cB, voffB); PG8_STAGE(PG8_SA(0, 0), cA, voffA); PG8_STAGE(PG8_SB(0, 1), cB + hstep, voffB); PG8_STAGE(PG8_SA(0, 1), cA + hstep, voffA);
        if (wr == 1) PG8_BAR;
        PG8_WAIT_V(4); PG8_BAR;
        PG8_STAGE(PG8_SB(1, 0), cB + kstep, voffB); PG8_STAGE(PG8_SA(1, 0), cA + kstep, voffA); PG8_STAGE(PG8_SB(1, 1), cB + hstep + kstep, voffB);
        PG8_WAIT_V(6); PG8_BAR;
    }
    for (;;) {
        const bool has_next = S.next(ui + 1, nxt);
        const char* nA = has_next ? (const char*)g.A + (size_t)nxt.pm * tstep + (size_t)nxt.pk * KL * 2 : cA; const char* nB = has_next ? (const char*)g.Bt + (size_t)nxt.pn * tstep + (size_t)nxt.pk * KL * 2 : cB;
        for (int t = 0; t < nt; t += 2) {
            const bool last = (t == nt - 2);
            const char* a1 = cA + (size_t)(t + 1) * kstep;
            const char* a2 = last ? nA : cA + (size_t)(t + 2) * kstep; const char* b2 = last ? nB : cB + (size_t)(t + 2) * kstep;
            const char* a3 = a2 + kstep; const char* b3 = b2 + kstep;
            if (last && has_next) S.a_ready(nxt);
            if constexpr (SP2) {
            PG8_LDB(B0, 0, 0); PG8_LDB(B1, 0, 1); PG8_SCHED; PG8_LDA(At, 0, 0); PG8_STAGE(PG8_SA(1, 1), a1 + hstep, voffA);
            PG8_WAIT_V(8); PG8_WAIT_L(0); PG8_BAR; PG8_MMA(0, 0, At, B0); PG8_MMA(0, 1, At, B1); PG8_BAR; PG8_SCHED;
            PG8_LDA(At, 0, 1); PG8_STAGE(PG8_SB(0, 0), b2, voffB); PG8_STAGE(PG8_SB(0, 1), b2 + hstep, voffB); PG8_STAGE(PG8_SA(0, 0), a2, voffA);
            PG8_WAIT_V(8); PG8_WAIT_L(0); PG8_BAR; PG8_MMA(1, 0, At, B0); PG8_MMA(1, 1, At, B1); PG8_BAR; PG8_SCHED;
            PG8_LDB(B0, 1, 0); PG8_LDB(B1, 1, 1); PG8_SCHED; PG8_LDA(At, 1, 0); PG8_STAGE(PG8_SA(0, 1), a2 + hstep, voffA);
            PG8_WAIT_V(8); PG8_WAIT_L(0); PG8_BAR; PG8_MMA(0, 0, At, B0); PG8_MMA(0, 1, At, B1); PG8_BAR; PG8_SCHED;
            PG8_LDA(At, 1, 1); PG8_STAGE(PG8_SB(1, 0), b3, voffB); PG8_STAGE(PG8_SB(1, 1), b3 + hstep, voffB); PG8_STAGE(PG8_SA(1, 0), a3, voffA);
            PG8_WAIT_V(8); PG8_WAIT_L(0); PG8_BAR; PG8_MMA(1, 0, At, B0); PG8_MMA(1, 1, At, B1); PG8_BAR; PG8_SCHED;
            } else {
            PG8_LDB(B0, 0, 0); PG8_SCHED; PG8_LDA(At, 0, 0); PG8_STAGE(PG8_SA(1, 1), a1 + hstep, voffA);
            PG8_WAIT_L(8); PG8_BAR; PG8_WAIT_L(0); PG8_MMA(0, 0, At, B0); PG8_BAR; PG8_SCHED;
            PG8_LDB(B1, 0, 1); PG8_STAGE(PG8_SB(0, 0), b2, voffB);
            PG8_BAR; PG8_WAIT_L(0); PG8_MMA(0, 1, At, B1); PG8_BAR;
            PG8_LDA(At, 0, 1); PG8_STAGE(PG8_SA(0, 0), a2, voffA);
            PG8_BAR; PG8_WAIT_L(0); PG8_MMA(1, 0, At, B0); PG8_BAR; PG8_SCHED;
            PG8_STAGE(PG8_SB(0, 1), b2 + hstep, voffB);
            PG8_WAIT_V(6); PG8_BAR; PG8_MMA(1, 1, At, B1); PG8_BAR;
            PG8_LDB(B0, 1, 0); PG8_SCHED; PG8_LDA(At, 1, 0); PG8_STAGE(PG8_SA(0, 1), a2 + hstep, voffA);
            PG8_WAIT_L(8); PG8_BAR; PG8_WAIT_L(0); PG8_MMA(0, 0, At, B0); PG8_BAR; PG8_SCHED;
            PG8_LDB(B1, 1, 1); PG8_STAGE(PG8_SB(1, 0), b3, voffB);
            PG8_BAR; PG8_WAIT_L(0); PG8_MMA(0, 1, At, B1); PG8_BAR;
            PG8_LDA(At, 1, 1); PG8_STAGE(PG8_SA(1, 0), a3, voffA);
            PG8_BAR; PG8_WAIT_L(0); PG8_MMA(1, 0, At, B0); PG8_BAR; PG8_SCHED;
            PG8_STAGE(PG8_SB(1, 1), b3 + hstep, voffB);
            PG8_WAIT_V(6); PG8_BAR; PG8_MMA(1, 1, At, B1); PG8_BAR;
            }
        }
        if constexpr (ALIGN_EPI) { if (wr == 0) PG8_BAR; }
        if constexpr (!Epi::AFTER_DRAIN) { E(acc, cur, wr, wc, fr, fq); S.done(cur); }
        if (!has_next) break;
#pragma unroll
        for (int a = 0; a < 2; ++a)
#pragma unroll
            for (int b = 0; b < 2; ++b)
#pragma unroll
                for (int m = 0; m < 4; ++m)
#pragma unroll
                    for (int n = 0; n < 2; ++n) acc[a][b][m][n] = (f32x4){0.f, 0.f, 0.f, 0.f};
        cur = nxt; cA = nA; cB = nB; ++ui;
        if constexpr (ALIGN_EPI) { if (wr == 1) PG8_BAR; }
    }
    PG8_WAIT_V(0);
    if constexpr (!ALIGN_EPI) { if (wr == 0) PG8_BAR; }
    PG8_BAR;
    if constexpr (Epi::AFTER_DRAIN) { E.fused(acc, cur, wr, wc, fr, fq, lds, wid, lane); S.done(cur); }
#undef PG8_SA
#undef PG8_SB
#undef PG8_STAGE
#undef PG8_LDA
#undef PG8_LDB
#undef PG8_MMA
#undef PG8_WAIT_V
#undef PG8_WAIT_L
#undef PG8_BAR
#undef PG8_SCHED
}
}
namespace att {
typedef unsigned short bf16;
using bf16x8 = __attribute__((ext_vector_type(8))) short;
using s16x4  = __attribute__((ext_vector_type(4))) short;
using f32x16 = __attribute__((ext_vector_type(16))) float;
using f32x4  = __attribute__((ext_vector_type(4))) float;
using u32x4  = __attribute__((ext_vector_type(4))) unsigned;
using u32x2  = __attribute__((ext_vector_type(2))) unsigned;
#define KSWZ(row, colB) ((row) * 256 + ((colB) ^ (((row) & 7) << 4)))
#define SBAR() __builtin_amdgcn_sched_barrier(0)
constexpr int L_K = 0, L_V = 32768, L_WS = 65536, L_TAB = 67584, L_STASH = 69632, L_END = L_STASH + 65536;
constexpr int SM_SLAB = 128 * 33 * 4, SM_OSUM = 0, SM_L = 8 * SM_SLAB, SM_LP = SM_L + 128, SM_M = SM_LP + 1024;
static_assert(SM_M + 1024 <= 139264, "small-body LDS map");
__device__ __forceinline__ int crow(int r, int hi) { return (r & 3) + 8 * (r >> 2) + 4 * hi; }
typedef float f32x2_cv __attribute__((ext_vector_type(2))); typedef __bf16 bf16x2_cv __attribute__((ext_vector_type(2)));
__device__ __forceinline__ unsigned cvtpk(float lo, float hi) { const f32x2_cv v = {lo, hi}; const bf16x2_cv b = __builtin_convertvector(v, bf16x2_cv); return __builtin_bit_cast(unsigned, b); }
__device__ __forceinline__ float bf2f(unsigned short h) { return __uint_as_float(((unsigned)h) << 16); }
__device__ __forceinline__ float ex2(float x) { return __builtin_amdgcn_exp2f(x); }
__device__ __forceinline__ float swapmax(float v) { auto rr = __builtin_amdgcn_permlane32_swap(__float_as_uint(v), __float_as_uint(v), false, false); return fmaxf(__uint_as_float(rr[0]), __uint_as_float(rr[1])); }
__device__ __forceinline__ float swapsum(float v) { auto rr = __builtin_amdgcn_permlane32_swap(__float_as_uint(v), __float_as_uint(v), false, false); return __uint_as_float(rr[0]) + __uint_as_float(rr[1]); }
__device__ __forceinline__ int v_st(int k, int c) { const int kk = (k & ~0xC) | ((k & 4) << 1) | ((k & 8) >> 1); return ((kk >> 3) * 4 + (c >> 5)) * 512 + ((kk & 7) * 32 + (c & 31)) * 2; }
__device__ __forceinline__ int v_rd_base(int lane) { return ((lane & 3) << 3) | (((lane >> 2) & 3) << 6) | (((lane >> 4) & 1) << 5) | (((lane >> 5) & 1) << 8); }
constexpr int v_rd_off(int d0, int ks, int half) { return d0 * 512 + ks * 4096 + half * 2048; }
template <int OFF> __device__ __forceinline__ s16x4 tr_read(int vb) { s16x4 r; asm volatile("ds_read_b64_tr_b16 %0, %1 offset:%2" : "=&v"(r) : "v"(vb), "i"(OFF) : "memory"); return r; }
template <int D0> __device__ __forceinline__ void pv_one(f32x16& od, int vb, bf16x8 pa0, bf16x8 pa1, bf16x8 pa2, bf16x8 pa3) {
  const s16x4 l0 = tr_read<v_rd_off(D0, 0, 0)>(vb), h0 = tr_read<v_rd_off(D0, 0, 1)>(vb), l1 = tr_read<v_rd_off(D0, 1, 0)>(vb), h1 = tr_read<v_rd_off(D0, 1, 1)>(vb);
  const s16x4 l2 = tr_read<v_rd_off(D0, 2, 0)>(vb), h2 = tr_read<v_rd_off(D0, 2, 1)>(vb), l3 = tr_read<v_rd_off(D0, 3, 0)>(vb), h3 = tr_read<v_rd_off(D0, 3, 1)>(vb);
  asm volatile("s_waitcnt lgkmcnt(0)" ::: "memory"); SBAR();
#define PK(L, H) (bf16x8){L[0], L[1], L[2], L[3], H[0], H[1], H[2], H[3]}
  od = __builtin_amdgcn_mfma_f32_32x32x16_bf16(pa0, PK(l0, h0), od, 0, 0, 0);
  od = __builtin_amdgcn_mfma_f32_32x32x16_bf16(pa1, PK(l1, h1), od, 0, 0, 0);
  od = __builtin_amdgcn_mfma_f32_32x32x16_bf16(pa2, PK(l2, h2), od, 0, 0, 0);
  od = __builtin_amdgcn_mfma_f32_32x32x16_bf16(pa3, PK(l3, h3), od, 0, 0, 0);
#undef PK
}
#define PK4(P, BASE, OUT) do { unsigned a0 = cvtpk(P[BASE + 0], P[BASE + 1]), a1 = cvtpk(P[BASE + 2], P[BASE + 3]);   \
    unsigned b0 = cvtpk(P[BASE + 4], P[BASE + 5]), b1 = cvtpk(P[BASE + 6], P[BASE + 7]);                              \
    auto r0 = __builtin_amdgcn_permlane32_swap(a0, b0, false, false); auto r1 = __builtin_amdgcn_permlane32_swap(a1, b1, false, false); \
    u32x4 w = {r0[0], r1[0], r0[1], r1[1]}; OUT = *reinterpret_cast<bf16x8*>(&w); } while (0)

template <int DQK, int DV, int MODE>
__device__ __forceinline__ void big_core(char* lds, const bf16* __restrict__ Qw, int ldq, const bf16* __restrict__ Kh, int ldk, const bf16* __restrict__ Vh, int ldv,
                                         int t_lo, int t_hi, int vis_lo, int vis_hi, int qpos_w, float slope2, f32x16 (&o)[DV / 32]) {
  int tid = threadIdx.x; asm volatile("" : "+v"(tid));
  const int wid = __builtin_amdgcn_readfirstlane(tid >> 6), lane = tid & 63, r32 = lane & 31, hi = lane >> 5;
  char* K_lds = lds + L_K; char* V_lds = lds + L_V;
  float* al_l = (float*)(lds + L_WS) + wid * 64; float* li_l = al_l + 32;
  const float* tab = (const float*)(lds + L_TAB);
  constexpr int NQ = DQK / 16, NO = DV / 32, NKL = DQK / 64, NVL = DV / 64, CPRK = DQK / 8, CPRV = DV / 8;
  bf16x8 qr[NQ];
#pragma unroll
  for (int d0 = 0; d0 < NQ; ++d0) qr[d0] = *reinterpret_cast<const bf16x8*>(Qw + (long)r32 * ldq + d0 * 16 + hi * 8);
#pragma unroll
  for (int d = 0; d < NO; ++d) o[d] = f32x16{};
  float m_reg = -1e30f, l_reg = 0.f;
  const int vb0 = (int)(uintptr_t)V_lds + v_rd_base(lane);
  bf16x8 ks_[NKL], vs_[NVL];
  bf16x8 qx = bf16x8{}, kx0 = bf16x8{}, kx1 = bf16x8{};
  if constexpr (MODE == 2) {
    if (hi == 0) {
      u32x4 wq = {0x3F803F80u, 0x00003F80u, 0u, 0u}; qx = *reinterpret_cast<bf16x8*>(&wq);
      const float v0 = slope2 * (float)r32, v1 = slope2 * (float)(32 + r32);
      const unsigned a1 = cvtpk(v0, 0.f) & 0xffffu; const float r1 = v0 - __uint_as_float(a1 << 16); const unsigned a2 = cvtpk(r1, 0.f) & 0xffffu; const float r2 = r1 - __uint_as_float(a2 << 16); const unsigned a3 = cvtpk(r2, 0.f) & 0xffffu;
      const unsigned b1 = cvtpk(v1, 0.f) & 0xffffu; const float s1 = v1 - __uint_as_float(b1 << 16); const unsigned b2 = cvtpk(s1, 0.f) & 0xffffu; const float s2 = s1 - __uint_as_float(b2 << 16); const unsigned b3 = cvtpk(s2, 0.f) & 0xffffu;
      u32x4 wa = {a1 | (a2 << 16), a3, 0u, 0u}, wb = {b1 | (b2 << 16), b3, 0u, 0u}; kx0 = *reinterpret_cast<bf16x8*>(&wa); kx1 = *reinterpret_cast<bf16x8*>(&wb);
    }
  }
#define SLOAD(t) do { _Pragma("unroll") for (int i = 0; i < NKL; ++i) { const int c = tid + 512 * i; ks_[i] = *reinterpret_cast<const bf16x8*>(Kh + (long)((t) * 64 + c / CPRK) * ldk + (c % CPRK) * 8); } \
                      _Pragma("unroll") for (int i = 0; i < NVL; ++i) { const int c = tid + 512 * i; vs_[i] = *reinterpret_cast<const bf16x8*>(Vh + (long)((t) * 64 + c / CPRV) * ldv + (c % CPRV) * 8); } } while (0)
#define SWRITE(b) do { _Pragma("unroll") for (int i = 0; i < NKL; ++i) { const int c = tid + 512 * i; *reinterpret_cast<bf16x8*>(K_lds + (b) * 16384 + KSWZ(c / CPRK, (c % CPRK) * 16)) = ks_[i]; } \
                       _Pragma("unroll") for (int i = 0; i < NVL; ++i) { const int c = tid + 512 * i; *reinterpret_cast<bf16x8*>(V_lds + (b) * 16384 + v_st(c / CPRV, (c % CPRV) * 8)) = vs_[i]; } } while (0)
  SLOAD(t_lo); SWRITE(0); __syncthreads();
  for (int t = t_lo; t < t_hi; ++t) {
    const int cur = (t - t_lo) & 1;
    const bool more = (t + 1 < t_hi);
    if (more) SLOAD(t + 1);
    if (t >= vis_lo && t <= vis_hi) {
      const char* Ks = K_lds + cur * 16384;
      const int rel0 = qpos_w + r32 - t * 64;
      f32x16 p0, p1;
      bool lookup = false;
      if (MODE == 1) { lookup = (qpos_w - (t * 64 + 63)) < 128; const float c = lookup ? 0.f : tab[256];
#pragma unroll
        for (int r = 0; r < 16; ++r) { p0[r] = c; p1[r] = c; } }
      else if (MODE == 2) { p0 = __builtin_amdgcn_mfma_f32_32x32x16_bf16(kx0, qx, f32x16{}, 0, 0, 0); p1 = __builtin_amdgcn_mfma_f32_32x32x16_bf16(kx1, qx, f32x16{}, 0, 0, 0); }
      else { p0 = f32x16{}; p1 = f32x16{}; }
#pragma unroll
      for (int dg = 0; dg < NQ; dg += 4) { bf16x8 kfa[4], kfb[4];
#pragma unroll
        for (int d0 = 0; d0 < 4; ++d0) { const int cb = ((dg + d0) * 16 + hi * 8) * 2;
          kfa[d0] = *reinterpret_cast<const bf16x8*>(Ks + KSWZ(r32, cb)); kfb[d0] = *reinterpret_cast<const bf16x8*>(Ks + KSWZ(32 + r32, cb)); }
        asm volatile("s_waitcnt lgkmcnt(0)" ::: "memory"); SBAR();
#pragma unroll
        for (int d0 = 0; d0 < 4; ++d0) { p0 = __builtin_amdgcn_mfma_f32_32x32x16_bf16(kfa[d0], qr[dg + d0], p0, 0, 0, 0); p1 = __builtin_amdgcn_mfma_f32_32x32x16_bf16(kfb[d0], qr[dg + d0], p1, 0, 0, 0); }
        SBAR(); }
      if (MODE == 1) { if (lookup) {
#pragma unroll
          for (int r = 0; r < 16; ++r) { const int i0 = min(rel0 - crow(r, hi), 128) + 128, i1 = min(rel0 - crow(r, hi) - 32, 128) + 128; p0[r] += tab[i0]; p1[r] += tab[i1]; } } }
      float Tt = 0.f;
      if (MODE == 2) { Tt = slope2 * (float)(t * 64);
        if (t == vis_hi) {
          asm volatile("; own-chunk ALiBi fix-up (a real branch: not to be if-converted)" ::: "memory");
          const float r0f = (float)(rel0 - 4 * hi), s2 = 2.f * slope2;
#pragma unroll
          for (int r = 0; r < 16; ++r) { const float c0 = (float)((r & 3) + 8 * (r >> 2)); p0[r] += s2 * fminf(r0f - c0, 0.f); p1[r] += s2 * fminf(r0f - c0 - 32.f, 0.f); } } }
      float pmax = p0[0];
#pragma unroll
      for (int r = 1; r < 16; ++r) pmax = fmaxf(pmax, p0[r]);
#pragma unroll
      for (int r = 0; r < 16; ++r) pmax = fmaxf(pmax, p1[r]);
      pmax = swapmax(pmax) + Tt;
      const float mnt = fmaxf(m_reg, pmax), alpha = ex2(m_reg - mnt); m_reg = mnt;
      const float mn = mnt - Tt;
      float ps = 0.f;
#pragma unroll
      for (int r = 0; r < 16; ++r) { p0[r] = ex2(p0[r] - mn); p1[r] = ex2(p1[r] - mn); ps += p0[r] + p1[r]; }
      ps = swapsum(ps);
      l_reg = l_reg * alpha + ps;
      bf16x8 pa0, pa1, pa2, pa3;
      PK4(p0, 0, pa0); PK4(p0, 8, pa1); PK4(p1, 0, pa2); PK4(p1, 8, pa3);
      if (__any(alpha < 1.f)) { if (hi == 0) al_l[r32] = alpha; asm volatile("s_waitcnt lgkmcnt(0)" ::: "memory");
#pragma unroll
        for (int d = 0; d < NO; ++d)
#pragma unroll
          for (int r = 0; r < 16; ++r) o[d][r] *= al_l[crow(r, hi)]; }
      const int vb = vb0 + cur * 16384;
      pv_one<0>(o[0], vb, pa0, pa1, pa2, pa3); pv_one<1>(o[1], vb, pa0, pa1, pa2, pa3);
      if constexpr (NO == 4) { pv_one<2>(o[2], vb, pa0, pa1, pa2, pa3); pv_one<3>(o[3], vb, pa0, pa1, pa2, pa3); }
    }
    if (more) SWRITE(cur ^ 1);
    __syncthreads();
  }
#undef SLOAD
#undef SWRITE
  if (hi == 0) li_l[r32] = l_reg; asm volatile("s_waitcnt lgkmcnt(0)" ::: "memory");
#pragma unroll
  for (int r = 0; r < 16; ++r) { const float rl = __builtin_amdgcn_rcpf(li_l[crow(r, hi)]);
#pragma unroll
    for (int d = 0; d < NO; ++d) o[d][r] *= rl; }
}
struct BigCtx { int r32, hi, vis_lo, vis_hi, qpos_w; float slope2; const float* tab; float* al_l; };
template <int DQK, int MODE>
__device__ __forceinline__ void bc2_qkt(f32x16& p0, f32x16& p1, const char* Ks, const bf16x8* qr, const BigCtx& c, int t, bf16x8 qx, bf16x8 kx0, bf16x8 kx1) {
  if (MODE == 1) { const bool lookup = (c.qpos_w - (t * 64 + 63)) < 128; const float cc = lookup ? 0.f : c.tab[256];
#pragma unroll
    for (int r = 0; r < 16; ++r) { p0[r] = cc; p1[r] = cc; } }
  else if (MODE == 2) { p0 = __builtin_amdgcn_mfma_f32_32x32x16_bf16(kx0, qx, f32x16{}, 0, 0, 0); p1 = __builtin_amdgcn_mfma_f32_32x32x16_bf16(kx1, qx, f32x16{}, 0, 0, 0); }
  else { p0 = f32x16{}; p1 = f32x16{}; }
#pragma unroll
  for (int dg = 0; dg < DQK / 16; dg += 4) { bf16x8 kfa[4], kfb[4];
#pragma unroll
    for (int d0 = 0; d0 < 4; ++d0) { const int cb = ((dg + d0) * 16 + c.hi * 8) * 2;
      kfa[d0] = *reinterpret_cast<const bf16x8*>(Ks + KSWZ(c.r32, cb)); kfb[d0] = *reinterpret_cast<const bf16x8*>(Ks + KSWZ(32 + c.r32, cb)); }
    asm volatile("s_waitcnt lgkmcnt(0)" ::: "memory");
#pragma unroll
    for (int d0 = 0; d0 < 4; ++d0) { asm volatile("" : "+v"(kfa[d0]), "+v"(kfb[d0]));
      p0 = __builtin_amdgcn_mfma_f32_32x32x16_bf16(kfa[d0], qr[dg + d0], p0, 0, 0, 0); p1 = __builtin_amdgcn_mfma_f32_32x32x16_bf16(kfb[d0], qr[dg + d0], p1, 0, 0, 0); } }
}
template <int MODE>
__device__ __forceinline__ void bc2_part(f32x16& p0, f32x16& p1, const BigCtx& c, int t, float& m_reg, float& mn, float& al) {
  const bool vis = (t >= c.vis_lo) && (t <= c.vis_hi);
  const int rel0 = c.qpos_w + c.r32 - t * 64;
  float Tt = 0.f;
  if (MODE == 1) { if (vis && (c.qpos_w - (t * 64 + 63)) < 128) {
#pragma unroll
      for (int r = 0; r < 16; ++r) { const int i0 = min(rel0 - crow(r, c.hi), 128) + 128, i1 = min(rel0 - crow(r, c.hi) - 32, 128) + 128; p0[r] += c.tab[i0]; p1[r] += c.tab[i1]; } } }
  if (MODE == 2) { Tt = c.slope2 * (float)(t * 64);
    if (t == c.vis_hi) { const float r0f = (float)(rel0 - 4 * c.hi), s2 = 2.f * c.slope2;
#pragma unroll
      for (int r = 0; r < 16; ++r) { const float c0 = (float)((r & 3) + 8 * (r >> 2)); p0[r] += s2 * fminf(r0f - c0, 0.f); p1[r] += s2 * fminf(r0f - c0 - 32.f, 0.f); } } }
  if (!vis) {
#pragma unroll
    for (int r = 0; r < 16; ++r) { p0[r] = -1e30f; p1[r] = -1e30f; } }
  float pmax = p0[0];
#pragma unroll
  for (int r = 1; r < 16; ++r) pmax = fmaxf(pmax, p0[r]);
#pragma unroll
  for (int r = 0; r < 16; ++r) pmax = fmaxf(pmax, p1[r]);
  pmax = swapmax(pmax) + Tt;
  const float mnt = fmaxf(m_reg, pmax); al = ex2(m_reg - mnt); m_reg = mnt; mn = mnt - Tt;
#pragma unroll
  for (int r = 0; r < 16; ++r) p0[r] = ex2(p0[r] - mn);
}
__device__ __forceinline__ void bc2_fin(f32x16& p0, f32x16& p1, float mn, float al, float& l_reg, bf16x8& pa0, bf16x8& pa1, bf16x8& pa2, bf16x8& pa3) {
#pragma unroll
  for (int r = 0; r < 16; ++r) p1[r] = ex2(p1[r] - mn);
  float ps = 0.f;
#pragma unroll
  for (int r = 0; r < 16; ++r) ps += p0[r];
#pragma unroll
  for (int r = 0; r < 16; ++r) ps += p1[r];
  ps = swapsum(ps);
  l_reg = l_reg * al + ps;
  PK4(p0, 0, pa0); PK4(p0, 8, pa1); PK4(p1, 0, pa2); PK4(p1, 8, pa3);
}
template <int NO>
__device__ __forceinline__ void bc2_pv(f32x16 (&o)[NO], int vb, bf16x8 pa0, bf16x8 pa1, bf16x8 pa2, bf16x8 pa3) {
  pv_one<0>(o[0], vb, pa0, pa1, pa2, pa3); pv_one<1>(o[1], vb, pa0, pa1, pa2, pa3);
  if constexpr (NO == 4) { pv_one<2>(o[2], vb, pa0, pa1, pa2, pa3); pv_one<3>(o[3], vb, pa0, pa1, pa2, pa3); }
}
template <int DQK, int DV, int MODE>
__device__ __forceinline__ void big_core2(char* lds, const bf16* __restrict__ Qw, int ldq, const bf16* __restrict__ Kh, int ldk, const bf16* __restrict__ Vh, int ldv,
                                          int t_lo, int t_hi, int vis_lo, int vis_hi, int qpos_w, float slope2, f32x16 (&o)[DV / 32]) {
  int tid = threadIdx.x; asm volatile("" : "+v"(tid));
  const int wid = __builtin_amdgcn_readfirstlane(tid >> 6), lane = tid & 63, r32 = lane & 31, hi = lane >> 5;
  char* K_lds = lds + L_K; char* V_lds = lds + L_V;
  float* al_l = (float*)(lds + L_WS) + wid * 64; float* li_l = al_l + 32;
  constexpr int NQ = DQK / 16, NO = DV / 32, NKL = DQK / 64, NVL = DV / 64, CPRK = DQK / 8, CPRV = DV / 8;
  BigCtx c; c.r32 = r32; c.hi = hi; c.vis_lo = vis_lo; c.vis_hi = vis_hi; c.qpos_w = qpos_w; c.slope2 = slope2; c.tab = (const float*)(lds + L_TAB); c.al_l = al_l;
  bf16x8 qr[NQ];
#pragma unroll
  for (int d0 = 0; d0 < NQ; ++d0) qr[d0] = *reinterpret_cast<const bf16x8*>(Qw + (long)r32 * ldq + d0 * 16 + hi * 8);
#pragma unroll
  for (int d = 0; d < NO; ++d) o[d] = f32x16{};
  float m_reg = -1e29f, l_reg = 0.f;
  const int vb0 = (int)(uintptr_t)V_lds + v_rd_base(lane);
  bf16x8 ks_[NKL], vs_[NVL];
  bf16x8 qx = bf16x8{}, kx0 = bf16x8{}, kx1 = bf16x8{};
  if constexpr (MODE == 2) {
    if (hi == 0) {
      u32x4 wq = {0x3F803F80u, 0x00003F80u, 0u, 0u}; qx = *reinterpret_cast<bf16x8*>(&wq);
      const float v0 = slope2 * (float)r32, v1 = slope2 * (float)(32 + r32);
      const unsigned a1 = cvtpk(v0, 0.f) & 0xffffu; const float r1 = v0 - __uint_as_float(a1 << 16); const unsigned a2 = cvtpk(r1, 0.f) & 0xffffu; const float r2 = r1 - __uint_as_float(a2 << 16); const unsigned a3 = cvtpk(r2, 0.f) & 0xffffu;
      const unsigned b1 = cvtpk(v1, 0.f) & 0xffffu; const float s1 = v1 - __uint_as_float(b1 << 16); const unsigned b2 = cvtpk(s1, 0.f) & 0xffffu; const float s2 = s1 - __uint_as_float(b2 << 16); const unsigned b3 = cvtpk(s2, 0.f) & 0xffffu;
      u32x4 wa = {a1 | (a2 << 16), a3, 0u, 0u}, wb = {b1 | (b2 << 16), b3, 0u, 0u}; kx0 = *reinterpret_cast<bf16x8*>(&wa); kx1 = *reinterpret_cast<bf16x8*>(&wb);
    }
  }
#define SLOAD(t) do { _Pragma("unroll") for (int i = 0; i < NKL; ++i) { const int cc_ = tid + 512 * i; ks_[i] = *reinterpret_cast<const bf16x8*>(Kh + (long)((t) * 64 + cc_ / CPRK) * ldk + (cc_ % CPRK) * 8); } \
                      _Pragma("unroll") for (int i = 0; i < NVL; ++i) { const int cc_ = tid + 512 * i; vs_[i] = *reinterpret_cast<const bf16x8*>(Vh + (long)((t) * 64 + cc_ / CPRV) * ldv + (cc_ % CPRV) * 8); } } while (0)
#define SWRITE(b) do { _Pragma("unroll") for (int i = 0; i < NKL; ++i) { const int cc_ = tid + 512 * i; *reinterpret_cast<bf16x8*>(K_lds + (b) * 16384 + KSWZ(cc_ / CPRK, (cc_ % CPRK) * 16)) = ks_[i]; } \
                       _Pragma("unroll") for (int i = 0; i < NVL; ++i) { const int cc_ = tid + 512 * i; *reinterpret_cast<bf16x8*>(V_lds + (b) * 16384 + v_st(cc_ / CPRV, (cc_ % CPRV) * 8)) = vs_[i]; } } while (0)
#define RESC(a) do { if (__any((a) < 1.f)) { if (hi == 0) al_l[r32] = (a); asm volatile("s_waitcnt lgkmcnt(0)" ::: "memory"); \
    _Pragma("unroll") for (int d = 0; d < NO; ++d) _Pragma("unroll") for (int r = 0; r < 16; ++r) o[d][r] *= al_l[crow(r, hi)]; } } while (0)
  f32x16 pA0, pA1, pB0, pB1; float mnA, mnB, alA, alB; bf16x8 pa0, pa1, pa2, pa3;
  const int NT = t_hi - t_lo;
  SLOAD(t_lo); SWRITE(0); __syncthreads();
  bc2_qkt<DQK, MODE>(pA0, pA1, K_lds, qr, c, t_lo, qx, kx0, kx1); bc2_part<MODE>(pA0, pA1, c, t_lo, m_reg, mnA, alA);
  SLOAD(t_lo + 1); SWRITE(1); __syncthreads();
  for (int j = 1; j + 1 < NT; j += 2) {
    SBAR(); bc2_qkt<DQK, MODE>(pB0, pB1, K_lds + 16384, qr, c, t_lo + j, qx, kx0, kx1);
    bc2_fin(pA0, pA1, mnA, alA, l_reg, pa0, pa1, pa2, pa3); SBAR();
    SLOAD(t_lo + j + 1); SBAR();
    bc2_pv<NO>(o, vb0, pa0, pa1, pa2, pa3); bc2_part<MODE>(pB0, pB1, c, t_lo + j, m_reg, mnB, alB);
    __syncthreads(); SWRITE(0);
    RESC(alB); __syncthreads();
    SBAR(); bc2_qkt<DQK, MODE>(pA0, pA1, K_lds, qr, c, t_lo + j + 1, qx, kx0, kx1);
    bc2_fin(pB0, pB1, mnB, alB, l_reg, pa0, pa1, pa2, pa3); SBAR();
    SLOAD(t_lo + j + 2); SBAR();
    bc2_pv<NO>(o, vb0 + 16384, pa0, pa1, pa2, pa3); bc2_part<MODE>(pA0, pA1, c, t_lo + j + 1, m_reg, mnA, alA);
    __syncthreads(); SWRITE(1);
    RESC(alA); __syncthreads();
  }
  SBAR(); bc2_qkt<DQK, MODE>(pB0, pB1, K_lds + 16384, qr, c, t_hi - 1, qx, kx0, kx1);
  bc2_fin(pA0, pA1, mnA, alA, l_reg, pa0, pa1, pa2, pa3); SBAR();
  bc2_pv<NO>(o, vb0, pa0, pa1, pa2, pa3); bc2_part<MODE>(pB0, pB1, c, t_hi - 1, m_reg, mnB, alB);
  RESC(alB);
  bc2_fin(pB0, pB1, mnB, alB, l_reg, pa0, pa1, pa2, pa3); SBAR();
  bc2_pv<NO>(o, vb0 + 16384, pa0, pa1, pa2, pa3);
  __syncthreads();
#undef SLOAD
#undef SWRITE
#undef RESC
  if (hi == 0) li_l[r32] = l_reg; asm volatile("s_waitcnt lgkmcnt(0)" ::: "memory");
#pragma unroll
  for (int r = 0; r < 16; ++r) { const float rl = __builtin_amdgcn_rcpf(li_l[crow(r, hi)]);
#pragma unroll
    for (int d = 0; d < NO; ++d) o[d][r] *= rl; }
}
template <int DV>
__device__ __forceinline__ void store_tile_bf16(char* stg, bf16* Ow, int ldo, const f32x16 (&o)[DV / 32]) {
  int tid_ = threadIdx.x; asm volatile("" : "+v"(tid_));
  const int lane = tid_ & 63, r32 = lane & 31, hi = lane >> 5;
  constexpr int PITCH = DV * 2, CPR = DV / 8;
#pragma unroll
  for (int d = 0; d < DV / 32; ++d)
#pragma unroll
    for (int r = 0; r < 16; ++r) *(unsigned short*)(stg + crow(r, hi) * PITCH + (d * 32 + r32) * 2) = (unsigned short)(cvtpk(o[d][r], 0.f) & 0xffffu);
  asm volatile("s_waitcnt lgkmcnt(0)" ::: "memory");
  u32x4 rb_[(32 * CPR) / 64];
#pragma unroll
  for (int i = 0; i < (32 * CPR) / 64; ++i) { const int c = i * 64 + lane, row = c / CPR, ch = c % CPR; rb_[i] = *(const u32x4*)(stg + row * PITCH + ch * 16); }
  asm volatile("s_waitcnt lgkmcnt(0)" ::: "memory");
#pragma unroll
  for (int i = 0; i < (32 * CPR) / 64; ++i) { const int c = i * 64 + lane, row = c / CPR, ch = c % CPR; *(u32x4*)(Ow + (long)row * ldo + ch * 8) = rb_[i]; }
  asm volatile("s_waitcnt lgkmcnt(0)" ::: "memory");
}

__device__ __forceinline__ const float* uniform_ptr(const float* p) {
  const unsigned long long v = (unsigned long long)p; const unsigned lo = __builtin_amdgcn_readfirstlane((unsigned)v), hi = __builtin_amdgcn_readfirstlane((unsigned)(v >> 32));
  return (const float*)(const __attribute__((address_space(1))) float*)(((unsigned long long)hi << 32) | lo);
}
template <int DQK, int DV, int MODE, int VB, bool PRE>
__device__ __forceinline__ void small_core(char* lds, const bf16* __restrict__ Qp, int ldq, const float* __restrict__ Kc, const float* __restrict__ Vc, int n0,
                                           const float* __restrict__ Kn, const float* __restrict__ Vn, int pitch, int qpos0, int kpos_c, int kpos_n, float slope2) {
  int tid = threadIdx.x; asm volatile("" : "+v"(tid));
  const int wid = __builtin_amdgcn_readfirstlane(tid >> 6), lane = tid & 63, r32 = lane & 31, hi = lane >> 5;
  float* Osum = (float*)(lds + SM_OSUM); float* lsum = (float*)(lds + SM_L); float* mbuf = (float*)(lds + SM_M);
  const float* tab = (const float*)(lds + L_TAB);
  constexpr int NQ = DQK / 16, NO = DV / 32;
  bf16x8 qr[NQ];
#pragma unroll
  for (int d0 = 0; d0 < NQ; ++d0) qr[d0] = *reinterpret_cast<const bf16x8*>(Qp + (long)r32 * ldq + d0 * 16 + hi * 8);
  f32x16 o[NO];
#pragma unroll
  for (int d = 0; d < NO; ++d) o[d] = f32x16{};
  float m_reg = -1e30f, l_reg = 0.f;
  const int nt0 = n0 / 32, nt = nt0 + (Kn ? 1 : 0);
  for (int t = wid; t < nt; t += 8) {
    const bool isnew = t >= nt0;
    const float* Kp = uniform_ptr(isnew ? Kn : Kc + (long)t * 32 * pitch);
    const float* Vp = uniform_ptr(isnew ? Vn : Vc + (long)t * 32 * pitch);
    const unsigned koffB = (unsigned)(r32 * pitch + hi * 8) * 4u, voffB = (unsigned)(4 * hi * pitch + r32) * 4u;
    const int kbase = isnew ? kpos_n : kpos_c + t * 32;
    float vfp[PRE ? DV / 32 : 1][2][8];
    if constexpr (PRE) {
#pragma unroll
      for (int db = 0; db < DV / 32; ++db)
#pragma unroll
        for (int s = 0; s < 2; ++s)
#pragma unroll
          for (int j = 0; j < 8; ++j) vfp[db][s][j] = *(const float*)((const char*)(Vp + (long)(16 * s + 8 * (j >> 2) + (j & 3)) * pitch + db * 32) + voffB);
    }
    const int rel0 = qpos0 + r32 - kbase;
    f32x16 p;
    bool lookup = false;
    if (MODE == 1) { lookup = (qpos0 - (kbase + 31)) < 128; const float c = lookup ? 0.f : tab[256];
#pragma unroll
      for (int r = 0; r < 16; ++r) p[r] = c; }
    else p = f32x16{};
#pragma unroll
    for (int kc = 0; kc < NQ; kc += 4) {
      f32x4 kf[4][2];
#pragma unroll
      for (int d0 = 0; d0 < 4; ++d0) { const char* kp = (const char*)(Kp + (kc + d0) * 16) + koffB; kf[d0][0] = *(const f32x4*)kp; kf[d0][1] = *(const f32x4*)(kp + 16); }
#pragma unroll
      for (int d0 = 0; d0 < 4; ++d0) { u32x4 w = {cvtpk(kf[d0][0][0], kf[d0][0][1]), cvtpk(kf[d0][0][2], kf[d0][0][3]), cvtpk(kf[d0][1][0], kf[d0][1][1]), cvtpk(kf[d0][1][2], kf[d0][1][3])};
        p = __builtin_amdgcn_mfma_f32_32x32x16_bf16(*reinterpret_cast<bf16x8*>(&w), qr[kc + d0], p, 0, 0, 0); }
      asm volatile("" ::: "memory");
    }
    if (MODE == 1) { if (lookup) {
#pragma unroll
        for (int r = 0; r < 16; ++r) p[r] += tab[min(rel0 - crow(r, hi), 128) + 128]; } }
    if (MODE == 2) {
#pragma unroll
      for (int r = 0; r < 16; ++r) p[r] -= slope2 * fabsf((float)(rel0 - crow(r, hi))); }
    float pmax = p[0];
#pragma unroll
    for (int r = 1; r < 16; ++r) pmax = fmaxf(pmax, p[r]);
    pmax = swapmax(pmax);
    const float mn = fmaxf(m_reg, pmax), alpha = ex2(m_reg - mn); m_reg = mn;
    float ps = 0.f;
#pragma unroll
    for (int r = 0; r < 16; ++r) { p[r] = ex2(p[r] - mn); ps += p[r]; }
    ps = swapsum(ps);
    l_reg = l_reg * alpha + ps;
#pragma unroll
    for (int d = 0; d < NO; ++d)
#pragma unroll
      for (int r = 0; r < 16; ++r) o[d][r] *= alpha;
    bf16x8 pb[2];
#pragma unroll
    for (int s = 0; s < 2; ++s) { u32x4 w = {cvtpk(p[8 * s + 0], p[8 * s + 1]), cvtpk(p[8 * s + 2], p[8 * s + 3]), cvtpk(p[8 * s + 4], p[8 * s + 5]), cvtpk(p[8 * s + 6], p[8 * s + 7])}; pb[s] = *reinterpret_cast<bf16x8*>(&w); }
    if constexpr (PRE) {
#pragma unroll
      for (int db = 0; db < NO; ++db)
#pragma unroll
        for (int s = 0; s < 2; ++s) { u32x4 w = {cvtpk(vfp[db][s][0], vfp[db][s][1]), cvtpk(vfp[db][s][2], vfp[db][s][3]), cvtpk(vfp[db][s][4], vfp[db][s][5]), cvtpk(vfp[db][s][6], vfp[db][s][7])};
          o[db] = __builtin_amdgcn_mfma_f32_32x32x16_bf16(*reinterpret_cast<bf16x8*>(&w), pb[s], o[db], 0, 0, 0); }
    } else {
#pragma unroll
    for (int dh = 0; dh < NO; dh += VB) {
      float vf[VB][2][8];
#pragma unroll
      for (int db = 0; db < VB; ++db)
#pragma unroll
        for (int s = 0; s < 2; ++s)
#pragma unroll
          for (int j = 0; j < 8; ++j) vf[db][s][j] = *(const float*)((const char*)(Vp + (long)(16 * s + 8 * (j >> 2) + (j & 3)) * pitch + (dh + db) * 32) + voffB);
#pragma unroll
      for (int db = 0; db < VB; ++db)
#pragma unroll
        for (int s = 0; s < 2; ++s) { u32x4 w = {cvtpk(vf[db][s][0], vf[db][s][1]), cvtpk(vf[db][s][2], vf[db][s][3]), cvtpk(vf[db][s][4], vf[db][s][5]), cvtpk(vf[db][s][6], vf[db][s][7])};
          o[dh + db] = __builtin_amdgcn_mfma_f32_32x32x16_bf16(*reinterpret_cast<bf16x8*>(&w), pb[s], o[dh + db], 0, 0, 0); }
      asm volatile("" ::: "memory");
    }
    }
  }
  if (hi == 0) mbuf[wid * 32 + r32] = m_reg;
  __syncthreads();
  float mx = mbuf[r32];
#pragma unroll
  for (int w = 1; w < 8; ++w) mx = fmaxf(mx, mbuf[w * 32 + r32]);
  const float sc = ex2(m_reg - mx);
  float* slab = (float*)(lds + SM_OSUM + wid * SM_SLAB); float* lpart = (float*)(lds + SM_LP);
  if (hi == 0) lpart[wid * 32 + r32] = l_reg * sc;
#pragma unroll
  for (int d = 0; d < NO; ++d)
#pragma unroll
    for (int r = 0; r < 16; ++r) slab[(d * 32 + crow(r, hi)) * 33 + r32] = o[d][r] * sc;
  __syncthreads();
  for (int e = tid; e < DV * 33; e += 512) { float t_[8];
#pragma unroll
    for (int w = 0; w < 8; ++w) t_[w] = Osum[w * (SM_SLAB / 4) + e];
    Osum[e] = ((t_[0] + t_[1]) + (t_[2] + t_[3])) + ((t_[4] + t_[5]) + (t_[6] + t_[7])); }
  if (tid < 32) { float a = lpart[tid];
#pragma unroll
    for (int w = 1; w < 8; ++w) a += lpart[w * 32 + tid];
    lsum[tid] = a; }
  __syncthreads();
}
#undef SBAR
}
constexpr int NWAVES = 8, NTHREADS = 512;
constexpr int LDSCTL_OFF = 139264, LDS_BYTES = 147456;
constexpr int CW_BAR = 4096;
static_assert(att::L_END <= LDSCTL_OFF && LDSCTL_OFF + 256 <= LDS_BYTES, "LDS map");
#define GAS __attribute__((address_space(1)))
#define LAS __attribute__((address_space(3)))
typedef unsigned short bf16;
typedef unsigned v4u __attribute__((ext_vector_type(4)));
typedef float f32x4 __attribute__((ext_vector_type(4)));
typedef short bf16x8 __attribute__((ext_vector_type(8)));
typedef GAS unsigned gu32;
typedef GAS unsigned long long gu64;
#define RLX_AGENT __ATOMIC_RELAXED, __HIP_MEMORY_SCOPE_AGENT
#define LDS_WAIT() asm volatile("s_waitcnt lgkmcnt(0)" ::: "memory")
#define VM_WAIT() asm volatile("s_waitcnt vmcnt(0)" ::: "memory")
__device__ __forceinline__ unsigned long long rt() { return __builtin_amdgcn_s_memrealtime(); }
__device__ __forceinline__ unsigned f2bf(float f) { unsigned u = __builtin_bit_cast(unsigned, f); return (u + 0x7fffu + ((u >> 16) & 1u)) >> 16; }
__device__ __forceinline__ unsigned pk2(float lo, float hi) { return f2bf(lo) | (f2bf(hi) << 16); }

#define XB_TMO      128
#define XB_XCNT(j)  (256  + 64 * (j))
#define XB_XSUB(j)  (1280 + 64 * (j))
#define XB_XGEN(j)  (2304 + 64 * (j))
#define XB_TOP      3328
#define XB_TOPGEN   3392
#define XCD_BAR_WORDS 3456
#define XB_SPIN_CAP (1u << 18)

__device__ __forceinline__ unsigned xb_ld(unsigned* p)              { return __hip_atomic_load(p, __ATOMIC_RELAXED, __HIP_MEMORY_SCOPE_AGENT); }
__device__ __forceinline__ unsigned xb_add(unsigned* p, unsigned v) { return __hip_atomic_fetch_add(p, v, __ATOMIC_RELAXED, __HIP_MEMORY_SCOPE_AGENT); }
__device__ __forceinline__ unsigned xb_xcc_id() { return (unsigned)__builtin_amdgcn_s_getreg((3 << 11) | 20) & 0xFu; }
#define XB_SPIN(cond, bar) do { unsigned _sp = 0; while (cond) { __builtin_amdgcn_s_sleep(1); \
    if ((++_sp & 255u) == 0u) { if (xb_ld(&(bar)[XB_TMO])) break; if (_sp > XB_SPIN_CAP) { atomicAdd(&(bar)[XB_TMO], 1u); break; } } } } while (0)

struct XcdBarrier {
    unsigned* bar; unsigned x;
    volatile LAS unsigned* st;
};

__device__ __forceinline__ XcdBarrier xcd_barrier_post(unsigned* bar, volatile LAS unsigned* st) {
    XcdBarrier b; b.bar = bar; b.x = xb_xcc_id(); b.st = st;
    if (threadIdx.x == 0) (void)xb_add(&bar[XB_XCNT(b.x)], 1u);
    return b;
}
__device__ __forceinline__ void xcd_barrier_complete(unsigned* bar, unsigned x, unsigned& nloc, unsigned& nx) {
    const unsigned G = gridDim.x * gridDim.y * gridDim.z;
    unsigned sum, cnt, mine, sp = 0u;
    for (;;) {
        sum = 0u; cnt = 0u; mine = 0u;
#pragma unroll
        for (unsigned j = 0; j < 16; ++j) { const unsigned c = xb_ld(&bar[XB_XCNT(j)]); sum += c; cnt += (c > 0u) ? 1u : 0u; mine = (j == x) ? c : mine; }
        if (sum == G) break;
        __builtin_amdgcn_s_sleep(1);
        if ((++sp & 255u) == 0u) { if (xb_ld(&bar[XB_TMO])) break; if (sp > XB_SPIN_CAP) { atomicAdd(&bar[XB_TMO], 1u); break; } }
    }
    nloc = mine > 0u ? mine : 1u; nx = cnt > 0u ? cnt : 1u;
}

__device__ __forceinline__ void xcd_barrier(const XcdBarrier& b) {
    asm volatile("s_waitcnt vmcnt(0)" ::: "memory");
    __syncthreads();
    if (threadIdx.x == 0) {
        unsigned* bar = b.bar;
        __builtin_amdgcn_s_waitcnt(0);
        unsigned nloc = b.st[0], nx = b.st[1];
        if (nloc == 0u) { xcd_barrier_complete(bar, b.x, nloc, nx); b.st[0] = nloc; b.st[1] = nx; }
        const unsigned old = xb_add(&bar[XB_XSUB(b.x)], 1u);
        const unsigned gen = old / nloc;
        if (old + 1u == (gen + 1u) * nloc) {
            __builtin_amdgcn_fence(__ATOMIC_RELEASE, "agent");
            asm volatile("s_waitcnt vmcnt(0)" ::: "memory");
            const unsigned og = xb_add(&bar[XB_TOP], 1u);
            const unsigned tg = og / nx;
            if (og + 1u == (tg + 1u) * nx) xb_add(&bar[XB_TOPGEN], 1u);
            else XB_SPIN(xb_ld(&bar[XB_TOPGEN]) == tg, bar);
            __builtin_amdgcn_fence(__ATOMIC_ACQUIRE, "agent");
            xb_add(&bar[XB_XGEN(b.x)], 1u);
            asm volatile("s_waitcnt vmcnt(0)" ::: "memory");
        } else {
            XB_SPIN(xb_ld(&bar[XB_XGEN(b.x)]) == gen, bar);
            __builtin_amdgcn_fence(__ATOMIC_ACQUIRE, "agent");
            asm volatile("s_waitcnt vmcnt(0)" ::: "memory");
        }
    }
    __syncthreads();
}

struct Args { const float* in[21]; float* out; unsigned char* ws; };
enum { I_XP = 0, I_XS, I_MEM, I_CAK, I_CAV, I_CBK, I_CBV, I_CMK, I_CMV, I_NG, I_WGU, I_WDN, I_WIN, I_RB, I_DL, I_SG, I_WOUT, I_MNG, I_WCQ, I_WCKV, I_WCO };

template <int X> __device__ __forceinline__ float lane_xor(float v) {
    return __int_as_float(__builtin_amdgcn_ds_swizzle(__float_as_int(v), (X << 10) | 0x1f));
}
__device__ __forceinline__ float wave_sum(float v) {
    v += lane_xor<1>(v); v += lane_xor<2>(v); v += lane_xor<4>(v); v += lane_xor<8>(v); v += lane_xor<16>(v);
    auto rr = __builtin_amdgcn_permlane32_swap(__float_as_uint(v), __float_as_uint(v), false, false);
    return __uint_as_float(rr[0]) + __uint_as_float(rr[1]);
}
__device__ __forceinline__ void transpose_item(const float* W, int K, int N, int k0, int ns0, bf16* WT, int nd0, LAS float* scr, int lane, const float* gain) {
    float wv[32];
    const float* wp = W + (size_t)(k0 + (lane >> 5)) * N + ns0 + (lane & 31);
#pragma unroll
    for (int i = 0; i < 32; ++i) wv[i] = wp[(size_t)(2 * i) * N];
    if (gain) { float gv[32]; const float* gp = gain + k0 + (lane >> 5);
#pragma unroll
        for (int i = 0; i < 32; ++i) gv[i] = gp[2 * i];
#pragma unroll
        for (int i = 0; i < 32; ++i) wv[i] *= gv[i]; }
#pragma unroll
    for (int i = 0; i < 32; ++i) scr[(2 * i + (lane >> 5)) * 33 + (lane & 31)] = wv[i];
    LDS_WAIT(); asm volatile("" ::: "memory");
    const int c = lane & 7;
#pragma unroll
    for (int j = 0; j < 4; ++j) { const int n = (lane >> 3) + 8 * j; const LAS float* s = scr + (8 * c) * 33 + n;
        v4u o; o.x = pk2(s[0 * 33], s[1 * 33]); o.y = pk2(s[2 * 33], s[3 * 33]); o.z = pk2(s[4 * 33], s[5 * 33]); o.w = pk2(s[6 * 33], s[7 * 33]);
        *(GAS v4u*)(WT + (size_t)(nd0 + n) * K + k0 + 8 * c) = o; }
    LDS_WAIT(); asm volatile("" ::: "memory");
}
__device__ __forceinline__ void norm_row(const float* xrow, const float* g, bf16* orow, int lane) {
    const GAS f32x4* xr = (const GAS f32x4*)xrow + lane; const GAS f32x4* gr = (const GAS f32x4*)g + lane;
    f32x4 v[4], gv[4]; float s = 0.f;
#pragma unroll
    for (int j = 0; j < 4; ++j) { v[j] = xr[64 * j]; gv[j] = gr[64 * j]; }
#pragma unroll
    for (int j = 0; j < 4; ++j) s += (v[j].x * v[j].x + v[j].y * v[j].y) + (v[j].z * v[j].z + v[j].w * v[j].w);
    const float r = rsqrtf(wave_sum(s) * (1.f / DM) + EPS);
    GAS unsigned long long* o8 = (GAS unsigned long long*)orow + lane;
#pragma unroll
    for (int j = 0; j < 4; ++j) { const f32x4 gg = gv[j];
        o8[64 * j] = (unsigned long long)pk2(v[j].x * r * gg.x, v[j].y * r * gg.y) | ((unsigned long long)pk2(v[j].z * r * gg.z, v[j].w * r * gg.w) << 32); }
}
__device__ __forceinline__ void cast_rows(int m0, int step, const float* xin_p, const float* xin_s, bf16* xb, float* rs, int lane) {
    f32x4 q[4];
#define CR_LOAD(m) do { const float* xs_ = (m) < MP ? xin_p + (size_t)(m) * DM : xin_s + (size_t)((m) - MP) * DM; const GAS f32x4* xr_ = (const GAS f32x4*)xs_ + lane; \
        _Pragma("unroll") for (int j = 0; j < 4; ++j) q[j] = xr_[64 * j]; } while (0)
    if (m0 < MTOT) CR_LOAD(m0);
    for (int m = m0; m < MTOT; m += step) {
        f32x4 v[4]; float s = 0.f;
#pragma unroll
        for (int j = 0; j < 4; ++j) { v[j] = q[j]; s += (v[j].x * v[j].x + v[j].y * v[j].y) + (v[j].z * v[j].z + v[j].w * v[j].w); }
        if (m + step < MTOT) CR_LOAD(m + step);
        const float r = rsqrtf(wave_sum(s) * (1.f / DM) + EPS);
        GAS unsigned long long* o8 = (GAS unsigned long long*)(xb + (size_t)m * DM) + lane;
#pragma unroll
        for (int j = 0; j < 4; ++j) o8[64 * j] = (unsigned long long)pk2(v[j].x, v[j].y) | ((unsigned long long)pk2(v[j].z, v[j].w) << 32);
        if (lane == 0) rs[m] = r;
    }
#undef CR_LOAD
}
template <int NSK>
__device__ __forceinline__ void resid_rows(int m0, int step, bool from_input, const float* xin_p, const float* xin_s, const bf16* ybase, bf16* xb, float* rs, float* xf,
                                           const float* gpost, float w, bool last, int lane, const float* ypart) {
    const GAS f32x4* gp = (const GAS f32x4*)gpost + lane;
    f32x4 gpv[4];
#pragma unroll
    for (int j = 0; j < 4; ++j) gpv[j] = gp[64 * j];
    f32x4 xq[4]; unsigned long long xbq[4], yq[4];
#define RR_LOAD(m) do { const GAS unsigned long long* yr_ = (const GAS unsigned long long*)(ybase + (size_t)(m) * DM) + lane; \
        if (from_input) { const float* xs_ = (m) < MP ? xin_p + (size_t)(m) * DM : xin_s + (size_t)((m) - MP) * DM; const GAS f32x4* xr_ = (const GAS f32x4*)xs_ + lane; \
            _Pragma("unroll") for (int j = 0; j < 4; ++j) { xq[j] = xr_[64 * j]; yq[j] = yr_[64 * j]; } } \
        else { const GAS unsigned long long* xr_ = (const GAS unsigned long long*)(xb + (size_t)(m) * DM) + lane; \
            _Pragma("unroll") for (int j = 0; j < 4; ++j) { xbq[j] = xr_[64 * j]; yq[j] = yr_[64 * j]; } } } while (0)
#define RR_UNPK(dst, q) do { const unsigned lo_ = (unsigned)(q), hi_ = (unsigned)((q) >> 32); \
        dst.x = __uint_as_float(lo_ << 16); dst.y = __uint_as_float(lo_ & 0xffff0000u); dst.z = __uint_as_float(hi_ << 16); dst.w = __uint_as_float(hi_ & 0xffff0000u); } while (0)
    if (m0 < MP) RR_LOAD(m0);
    for (int m = m0; m < MP; m += step) {
        f32x4 x[4], y[4]; float s = 0.f;
#pragma unroll
        for (int j = 0; j < 4; ++j) { if (from_input) x[j] = xq[j]; else RR_UNPK(x[j], xbq[j]); RR_UNPK(y[j], yq[j]);
            s += (y[j].x * y[j].x + y[j].y * y[j].y) + (y[j].z * y[j].z + y[j].w * y[j].w); }
        if (m + step < MP) RR_LOAD(m + step);
        const float ry = rsqrtf(wave_sum(s) * (1.f / DM) + EPS) * w;
        float s2 = 0.f;
#pragma unroll
        for (int j = 0; j < 4; ++j) { x[j] = x[j] + y[j] * gpv[j] * ry; s2 += (x[j].x * x[j].x + x[j].y * x[j].y) + (x[j].z * x[j].z + x[j].w * x[j].w); }
        if (last) { GAS f32x4* xo = (GAS f32x4*)(xf + (size_t)m * DM) + lane;
#pragma unroll
            for (int j = 0; j < 4; ++j) xo[64 * j] = x[j]; }
        else { GAS unsigned long long* o8 = (GAS unsigned long long*)(xb + (size_t)m * DM) + lane;
#pragma unroll
            for (int j = 0; j < 4; ++j) o8[64 * j] = (unsigned long long)pk2(x[j].x, x[j].y) | ((unsigned long long)pk2(x[j].z, x[j].w) << 32);
            const float rx = rsqrtf(wave_sum(s2) * (1.f / DM) + EPS);
            if (lane == 0) rs[m] = rx; }
    }
    for (int m = MP + m0; m < MTOT; m += step) {
        f32x4 x[4], y[4]; float s = 0.f;
        if (from_input) { const GAS f32x4* xr_ = (const GAS f32x4*)(xin_s + (size_t)(m - MP) * DM) + lane;
#pragma unroll
            for (int j = 0; j < 4; ++j) x[j] = xr_[64 * j]; }
        else { const GAS unsigned long long* xr_ = (const GAS unsigned long long*)(xb + (size_t)m * DM) + lane; unsigned long long q_[4];
#pragma unroll
            for (int j = 0; j < 4; ++j) q_[j] = xr_[64 * j];
#pragma unroll
            for (int j = 0; j < 4; ++j) RR_UNPK(x[j], q_[j]); }
#pragma unroll
        for (int j = 0; j < 4; ++j) y[j] = (f32x4){0.f, 0.f, 0.f, 0.f};
#pragma unroll
        for (int k0 = 0; k0 < NSK; k0 += 6) { f32x4 t_[6][4];
#pragma unroll
            for (int kk = 0; kk < 6; ++kk) if (k0 + kk < NSK) { const GAS f32x4* yr_ = (const GAS f32x4*)(ypart + ((size_t)(k0 + kk) * MS + (m - MP)) * DM) + lane;
#pragma unroll
                for (int j = 0; j < 4; ++j) t_[kk][j] = yr_[64 * j]; }
#pragma unroll
            for (int kk = 0; kk < 6; ++kk) if (k0 + kk < NSK) {
#pragma unroll
                for (int j = 0; j < 4; ++j) y[j] = y[j] + t_[kk][j]; } }
#pragma unroll
        for (int j = 0; j < 4; ++j) s += (y[j].x * y[j].x + y[j].y * y[j].y) + (y[j].z * y[j].z + y[j].w * y[j].w);
        const float ry = rsqrtf(wave_sum(s) * (1.f / DM) + EPS) * w;
        float s2 = 0.f;
#pragma unroll
        for (int j = 0; j < 4; ++j) { x[j] = x[j] + y[j] * gpv[j] * ry; s2 += (x[j].x * x[j].x + x[j].y * x[j].y) + (x[j].z * x[j].z + x[j].w * x[j].w); }
        if (last) { GAS f32x4* xo = (GAS f32x4*)(xf + (size_t)m * DM) + lane;
#pragma unroll
            for (int j = 0; j < 4; ++j) xo[64 * j] = x[j]; }
        else { GAS unsigned long long* o8 = (GAS unsigned long long*)(xb + (size_t)m * DM) + lane;
#pragma unroll
            for (int j = 0; j < 4; ++j) o8[64 * j] = (unsigned long long)pk2(x[j].x, x[j].y) | ((unsigned long long)pk2(x[j].z, x[j].w) << 32);
            const float rx = rsqrtf(wave_sum(s2) * (1.f / DM) + EPS);
            if (lane == 0) rs[m] = rx; }
    }
#undef RR_LOAD
#undef RR_UNPK
}
#ifndef REP_PC
#define REP_PC 1
#endif
#ifndef REP_SC
#define REP_SC 1
#endif
#ifndef BIGC_BAND
#define BIGC_BAND big_core
#endif
#ifndef BIGC_DIFF
#define BIGC_DIFF big_core
#endif
#ifndef BIGC_CROSS
#define BIGC_CROSS big_core2
#endif
#ifndef REP_GEMM
#define REP_GEMM 1
#endif
#ifndef REP_GEMM
#define REP_GEMM 1
#endif
#ifndef REP_GU
#define REP_GU REP_GEMM
#endif
#ifndef REP_DN
#define REP_DN REP_GEMM
#endif
#ifndef REP_IN
#define REP_IN REP_GEMM
#endif
#ifndef REP_OUT
#define REP_OUT REP_GEMM
#endif
#ifndef REP_CQ
#define REP_CQ REP_GEMM
#endif
#ifndef REP_CO
#define REP_CO REP_GEMM
#endif
#ifndef GEMM_ALIGN
#define GEMM_ALIGN true
#endif
#ifndef REP_ATT
#define REP_ATT 1
#endif
#ifndef REP_A
#define REP_A REP_ATT
#endif
#ifndef REP_B
#define REP_B REP_ATT
#endif
#ifndef REP_C
#define REP_C REP_ATT
#endif
#ifndef EN_ALL
#define EN_ALL 1
#endif
#ifndef EN_SDIFF
#define EN_SDIFF EN_ALL
#endif
#ifndef EN_SBAND
#define EN_SBAND EN_ALL
#endif
#ifndef EN_PBAND
#define EN_PBAND EN_ALL
#endif
#ifndef EN_PDIFF
#define EN_PDIFF EN_ALL
#endif
#ifndef EN_SCROSS
#define EN_SCROSS EN_ALL
#endif
#ifndef EN_PCROSS
#define EN_PCROSS EN_ALL
#endif
#ifndef EN_GEMM
#define EN_GEMM EN_ALL
#endif
#ifndef EN_GU1
#define EN_GU1 EN_GEMM
#endif
#ifndef EN_DN1
#define EN_DN1 EN_GEMM
#endif
#ifndef EN_WIN_
#define EN_WIN_ EN_GEMM
#endif
#ifndef EN_WOUT_
#define EN_WOUT_ EN_GEMM
#endif
#ifndef EN_WCQ_
#define EN_WCQ_ EN_GEMM
#endif
#ifndef EN_WCO_
#define EN_WCO_ EN_GEMM
#endif
#ifndef EN_GU2
#define EN_GU2 EN_GEMM
#endif
#ifndef EN_DN2
#define EN_DN2 EN_GEMM
#endif
#ifndef EN_MEMKV
#define EN_MEMKV EN_GEMM
#endif

__device__ __forceinline__ unsigned long long karg_u64(int byte_off) {
    unsigned long long v; const unsigned long long ka = (unsigned long long)__builtin_amdgcn_kernarg_segment_ptr();
    asm volatile("s_load_dwordx2 %0, %1, %2\n\ts_waitcnt lgkmcnt(0)" : "=s"(v) : "s"(ka), "i"(byte_off) : "memory");
    return v;
}
#define INP(i) ((const float*)(const GAS float*)karg_u64(8 * (i)))
#define OUTP() ((float*)(GAS float*)karg_u64(168))
#define WSP() ((unsigned char*)(GAS unsigned char*)karg_u64(176))
#define WGU ((bf16*)(WSP() + WS_WGU))
#define WDN ((bf16*)(WSP() + WS_WDN))
#define WIN ((bf16*)(WSP() + WS_WIN))
#define WOUT ((bf16*)(WSP() + WS_WOUT))
#define WCQ ((bf16*)(WSP() + WS_WCQ))
#define WCKV ((bf16*)(WSP() + WS_WCKV))
#define WCO ((bf16*)(WSP() + WS_WCO))
#define XN ((bf16*)(WSP() + WS_XN))
#define ACT ((bf16*)(WSP() + WS_ACT))
#define Y ((bf16*)(WSP() + WS_Y))
#define QKV ((bf16*)(WSP() + WS_QKV))
#define MIX ((bf16*)(WSP() + WS_MIX))
#define QC ((bf16*)(WSP() + WS_QC))
#define OC ((bf16*)(WSP() + WS_OC))
#define MEMN ((bf16*)(WSP() + WS_MEMN))
#define MKV ((bf16*)(WSP() + WS_MKV))
#define OS ((float*)(WSP() + WS_OS))
#define RS ((float*)(WSP() + WS_RS))
#define YP ((float*)(WSP() + WS_YP))
#define out OUTP()
static_assert(sizeof(Args) == 184, "kernarg layout");

__global__ void __launch_bounds__(NTHREADS, 2) fwd_kernel(Args args) {
    extern __shared__ __attribute__((aligned(16))) unsigned char lds[];
    LAS unsigned char* ldsl = (LAS unsigned char*)lds;
    char* ldsg = (char*)lds;
#define FRESH_IDS() int G = G0, bx = bx0, vcu = vcu0; asm volatile("" : "+s"(G), "+s"(bx), "+s"(vcu)); const int NGW = G * NWAVES; (void)NGW; (void)bx; (void)vcu
#define FRESH_TID() FRESH_IDS(); int tid = threadIdx.x; asm volatile("" : "+v"(tid)); const int lane = tid & 63, wave = __builtin_amdgcn_readfirstlane(tid >> 6), gw = vcu * NWAVES + wave; (void)lane; (void)gw
    const int G0 = gridDim.x, bx0 = blockIdx.x;
    const int vcu0 = (G0 % 8 == 0) ? (bx0 % 8) * (G0 / 8) + bx0 / 8 : bx0;
    { FRESH_TID(); for (int u = tid; u < (LDS_BYTES - LDSCTL_OFF) / 4; u += NTHREADS) ((LAS unsigned*)(ldsl + LDSCTL_OFF))[u] = 0u; }
    __syncthreads();
    (void)xcd_barrier_post((unsigned*)(WSP() + WS_CTL) + CW_BAR, (volatile LAS unsigned*)(ldsl + LDSCTL_OFF) + 8);
#define GRID_BAR() do { XcdBarrier b_; b_.bar = (unsigned*)(WSP() + WS_CTL) + CW_BAR; b_.x = xb_xcc_id(); b_.st = (volatile LAS unsigned*)(ldsl + LDSCTL_OFF) + 8; xcd_barrier(b_); } while (0)

#define CONVERT_ITEMS(LY, I0, I1, W0, NW) do { LAS float* scr = (LAS float*)(ldsl + wave * 16384); \
        for (int it = (I0) + (W0); it < (I1); it += (NW)) { int r = it; \
            if (r < 5632) { const int mi = (LY) * 2 + r / 2816, rr = r % 2816, kb = rr / 176, nb = rr % 176, nd0 = nb * 32, pn = nd0 >> 8, wi = nd0 & 255, bj = wi >> 7, j0 = wi & 127; \
                transpose_item(INP(I_WGU) + (size_t)mi * DM * NGU, DM, NGU, kb * 64, bj * DFF + 128 * pn + j0, WGU + (size_t)mi * NGU * DM, nd0, scr, lane, INP(I_NG) + (size_t)((mi >> 1) * 8 + (mi & 1) * 6) * DM); continue; } r -= 5632; \
            if (r < 2816) { const int mi = (LY) * 2 + r / 1408, rr = r % 1408, kb = rr / 32, nb = rr % 32; \
                transpose_item(INP(I_WDN) + (size_t)mi * DFF * DM, DFF, DM, kb * 64, nb * 32, WDN + (size_t)mi * DM * DFF, nb * 32, scr, lane, nullptr); continue; } r -= 2816; \
            if (r < 1536) { const int mi = (LY), kb = r / 96, nb = r % 96; \
                transpose_item(INP(I_WIN) + (size_t)mi * DM * NIN, DM, NIN, kb * 64, nb * 32, WIN + (size_t)mi * NIN * DM, nb * 32, scr, lane, INP(I_NG) + (size_t)(mi * 8 + 2) * DM); continue; } r -= 1536; \
            if (r < 512) { const int mi = (LY), kb = r / 32, nb = r % 32; \
                transpose_item(INP(I_WOUT) + (size_t)mi * DM * DM, DM, DM, kb * 64, nb * 32, WOUT + (size_t)mi * DM * DM, nb * 32, scr, lane, nullptr); continue; } r -= 512; \
            if (r < 256) { const int mi = (LY), kb = r / 16, nb = r % 16; \
                transpose_item(INP(I_WCQ) + (size_t)mi * DM * 512, DM, 512, kb * 64, nb * 32, WCQ + (size_t)mi * 512 * DM, nb * 32, scr, lane, INP(I_NG) + (size_t)(mi * 8 + 4) * DM); continue; } r -= 256; \
            { const int mi = (LY), kb = r / 32, nb = r % 32; \
                transpose_item(INP(I_WCO) + (size_t)mi * 512 * DM, 512, DM, kb * 64, nb * 32, WCO + (size_t)mi * DM * 512, nb * 32, scr, lane, nullptr); } } } while (0)
    constexpr int CV_ITEMS = 5632 + 2816 + 1536 + 512 + 256 + 256;
    {
        FRESH_TID();
        CONVERT_ITEMS(0, 0, CV_ITEMS, gw, NGW);
        { LAS float* scr = (LAS float*)(ldsl + wave * 16384);
          for (int r = gw; r < 1024; r += NGW) { const int mi = r / 512, rr = r % 512, kb = rr / 32, nb = rr % 32;
            transpose_item(INP(I_WCKV) + (size_t)mi * DM * DM, DM, DM, kb * 64, nb * 32, WCKV + (size_t)mi * DM * DM, nb * 32, scr, lane, nullptr); } }
        cast_rows(gw, NGW, INP(I_XP), INP(I_XS), XN, RS, lane);
        { const float* const mem_ = INP(I_MEM); const float* const mg_ = INP(I_MNG); bf16* const mn_ = MEMN;
          for (int m = gw; m < 2 * MMEM; m += NGW) { const int l = m / MMEM, r = m % MMEM; norm_row(mem_ + (size_t)r * DM, mg_ + l * DM, mn_ + (size_t)m * DM, lane); } }
    }
    GRID_BAR();

#define GEMM_STATIC(REPN, Aptr, Bptr, Nn, Kk, EpiT, EpiObj) do { for (int rep_ = 0; rep_ < (REPN); ++rep_) { if (rep_) GRID_BAR(); FRESH_IDS(); pg8::Gemm g_{(const pg8::bf16_t*)(Aptr), (const pg8::bf16_t*)(Bptr), MTOT, (Nn), (Kk), 0}; pg8::StaticOrder S_; S_.init(MTOT, (Nn), G, bx); \
        pg8::gemm_phase<EpiT, pg8::StaticOrder, GEMM_ALIGN, true>(ldsl, g_, S_, (EpiObj)); } } while (0)
#define GEMM_SPLIT(REPN, Aptr, Bptr, Kk, SKk) do { for (int rep_ = 0; rep_ < (REPN); ++rep_) { if (rep_) GRID_BAR(); FRESH_IDS(); \
        { pg8::Gemm g_{(const pg8::bf16_t*)(Aptr), (const pg8::bf16_t*)(Bptr), MP, DM, (Kk), 0}; pg8::StaticOrder S_; S_.init(MP, DM, G, bx); pg8::EpiPlain E_{(pg8::bf16_t*)Y, DM, 1.0f, nullptr}; \
          pg8::gemm_phase<pg8::EpiPlain, pg8::StaticOrder, true, true>(ldsl, g_, S_, E_); } \
        { pg8::Gemm g_{(const pg8::bf16_t*)(Aptr), (const pg8::bf16_t*)(Bptr), MTOT, DM, (Kk), (Kk) / (SKk)}; pg8::SplitOrder S_; S_.init(MP / 256, MS / 256, DM / 256, (SKk), G, bx); \
          pg8::EpiPartial E_{YP, DM, MP, (size_t)MS * DM}; pg8::gemm_phase<pg8::EpiPartial, pg8::SplitOrder, true, true>(ldsl, g_, S_, E_); } } } while (0)
#define THIN(XSRC_IS_INPUT, GPOST, WGT, LAST, NSK) do { FRESH_TID(); \
        resid_rows<NSK>(gw, NGW, (XSRC_IS_INPUT), INP(I_XP), INP(I_XS), Y, XN, RS, out, (GPOST), (WGT), (LAST), lane, YP); } while (0)

    for (int l = 0; l < DEPTH; ++l) {
        const float* ng = INP(I_NG) + (size_t)l * 8 * DM;
        if (EN_GU1) { pg8::EpiSwiGLU E{(pg8::bf16_t*)ACT, DFF, RS}; GEMM_STATIC(REP_GU, XN, WGU + (size_t)(l * 2 + 0) * NGU * DM, NGU, DM, pg8::EpiSwiGLU, E); }
        if (EN_MEMKV && l == 0) {
#pragma unroll
            for (int ml = 0; ml < 2; ++ml) { FRESH_IDS(); pg8::Gemm g_{(const pg8::bf16_t*)(MEMN + (size_t)ml * MMEM * DM), (const pg8::bf16_t*)(WCKV + (size_t)ml * DM * DM), MMEM, DM, DM, 0};
                pg8::SubsetOrder S_; S_.init(MMEM / 256, 4, 32, bx - 88 - 32 * ml); pg8::EpiMemKV E{(pg8::bf16_t*)(MKV + (size_t)ml * MMEM * 1024), out, ml};
                pg8::gemm_phase<pg8::EpiMemKV, pg8::SubsetOrder, true, true>(ldsl, g_, S_, E); }
        }
        if (l == 0 && bx0 >= 152) { FRESH_TID(); CONVERT_ITEMS(1, 0, 5632, (bx - 152) * NWAVES + wave, (G - 152) * NWAVES); }
        GRID_BAR();
        if (EN_DN1) GEMM_SPLIT(REP_DN, ACT, WDN + (size_t)(l * 2 + 0) * DM * DFF, DFF, 11);
        GRID_BAR();
        THIN(l == 0, ng + 1 * DM, 0.5f, false, 11);
        GRID_BAR();
        if (EN_WIN_) { pg8::EpiQKV E{(pg8::bf16_t*)QKV, out, l, RS}; GEMM_STATIC(REP_IN, XN, WIN + (size_t)l * NIN * DM, NIN, DM, pg8::EpiQKV, E); }
        if (l == 0 && bx0 >= 48) { FRESH_TID(); CONVERT_ITEMS(1, 5632, CV_ITEMS, (bx - 48) * NWAVES + wave, (G - 48) * NWAVES); }
        GRID_BAR();
        for (int rep_ = 0; rep_ < REP_A; ++rep_) {
            if (rep_) GRID_BAR();
            FRESH_TID();
            for (int ord_ = 0; ord_ < 2; ++ord_) {
            if ((ord_ == 0) != (((vcu >> 3) & 1) != 0)) {
            if (EN_SDIFF && vcu < SB * 4 * 2) {
                const int b = vcu >> 3, h = (vcu >> 1) & 3, mp = vcu & 1;
                const float slope2 = exp2f(-2.0f * (float)(h + 1)) * LOG2E;
                const float* Kc = INP(I_CBK) + ((size_t)(l * SB + b) * PAST) * 512 + h * 128 + mp * 64;
                const float* Vc = INP(I_CBV) + ((size_t)(l * SB + b) * PAST) * 512 + h * 128;
                const float* Kn = out + O_SBK + ((size_t)l * MS + b * ST) * 512 + h * 128 + mp * 64;
                const float* Vn = out + O_SBV + ((size_t)l * MS + b * ST) * 512 + h * 128;
                att::small_core<64, 128, 2, 4, true>(ldsg, (const att::bf16*)QKV + (size_t)(MP + b * ST) * NIN + 1536 + h * 128 + mp * 64, NIN, Kc, Vc, PAST, Kn, Vn, 512, PAST, 0, PAST, slope2);
                const float* Osum = (const float*)(ldsg + att::SM_OSUM); const float* lsum = (const float*)(ldsg + att::SM_L);
                float* od = OS + (size_t)mp * MS * 512 + (size_t)(b * ST) * 512 + h * 128;
                for (int i = tid; i < 32 * 128; i += NTHREADS) { const int q = i >> 7, d = i & 127; od[(size_t)q * 512 + d] = Osum[d * 33 + q] / lsum[q]; }
                __syncthreads();
            }
            if (EN_SBAND && vcu < SB * 8) {
                const int b = vcu >> 3, h = vcu & 7;
                if (tid < 257) ((float*)(ldsg + att::L_TAB))[tid] = INP(I_RB)[(size_t)(l * 8 + h) * 257 + tid] * LOG2E;
                __syncthreads();
                const float* Kc = INP(I_CAK) + ((size_t)(l * SB + b) * WA) * 512 + h * 64;
                const float* Vc = INP(I_CAV) + ((size_t)(l * SB + b) * WA) * 512 + h * 64;
                const float* Kn = out + O_SAK + ((size_t)l * MS + b * ST) * 512 + h * 64;
                const float* Vn = out + O_SAV + ((size_t)l * MS + b * ST) * 512 + h * 64;
                att::small_core<64, 64, 1, 2, true>(ldsg, (const att::bf16*)QKV + (size_t)(MP + b * ST) * NIN + h * 64, NIN, Kc, Vc, WA, Kn, Vn, 512, PAST, PAST - WA, PAST, 0.f);
                const float* Osum = (const float*)(ldsg + att::SM_OSUM); const float* lsum = (const float*)(ldsg + att::SM_L);
                bf16* od = MIX + (size_t)(MP + b * ST) * DM + h * 64;
                for (int i = tid; i < 32 * 64; i += NTHREADS) { const int q = i >> 6, d = i & 63; od[(size_t)q * DM + d] = (bf16)f2bf(Osum[d * 33 + q] / lsum[q]); }
                __syncthreads();
            }
            } else {
            if (EN_PBAND && tid < 257) ((float*)(ldsg + att::L_TAB))[tid] = INP(I_RB)[(size_t)(l * 8 + ((vcu >> 2) & 7)) * 257 + tid] * LOG2E;
            for (int i = 0; EN_PBAND && i < 4; ++i) {
                const int u = vcu * 4 + i; if (u >= PB * 8 * 16) break;
                const int bh = u >> 4, qb = u & 15, b = bh >> 3, h = bh & 7, q0 = qb * 256; const size_t rowbase = (size_t)b * PT;
                const int cw = 4 * qb + (wave >> 1);
                att::f32x16 o[2];
                att::BIGC_BAND<64, 64, 1>(ldsg, (const att::bf16*)QKV + (rowbase + q0 + wave * 32) * NIN + h * 64, NIN, (const att::bf16*)QKV + rowbase * NIN + 512 + h * 64, NIN,
                                         (const att::bf16*)QKV + rowbase * NIN + 1024 + h * 64, NIN, max(0, 4 * qb - 8), 4 * qb + 4, cw - 8, cw, q0 + wave * 32, 0.f, o);
                att::store_tile_bf16<64>(ldsg + wave * 4096, (att::bf16*)MIX + (rowbase + q0 + wave * 32) * DM + h * 64, DM, o);
                __syncthreads();
            }
                    }
            }
        }
        GRID_BAR();
        for (int rep_ = 0; rep_ < REP_B; ++rep_) {
            if (rep_) GRID_BAR();
            FRESH_TID();
            const float lam_init = 0.8f - 0.6f * expf(-0.3f * (float)l);
            const float* dl = INP(I_DL) + (size_t)l * 256;
            const float lam = expf(wave_sum(dl[lane] * dl[64 + lane])) - expf(wave_sum(dl[128 + lane] * dl[192 + lane])) + lam_init;
            const float* sg = INP(I_SG) + (size_t)l * 128;
            const float gsc = 1.0f - lam_init;
            if (EN_PDIFF && vcu < PB * 4 * 8) {
                const int bh = vcu >> 3, sidx = vcu & 7, b = bh >> 2, h = bh & 3; const size_t rowbase = (size_t)b * PT;
                const float slope2 = exp2f(-2.0f * (float)(h + 1)) * LOG2E;
                const int r32 = lane & 31, hi = lane >> 5;
                for (int half = 0; half < 2; ++half) {
                    const int qb = half == 0 ? sidx : 15 - sidx, q0 = qb * 256, cw = 4 * qb + (wave >> 1);
                    unsigned short* stash = (unsigned short*)(ldsg + att::L_STASH + wave * 8192);
                    att::f32x16 o[4];
                    for (int mp = 0; mp < 2; ++mp) {
                        att::BIGC_DIFF<64, 128, 2>(ldsg, (const att::bf16*)QKV + (rowbase + q0 + wave * 32) * NIN + 1536 + h * 128 + mp * 64, NIN,
                                                  (const att::bf16*)QKV + rowbase * NIN + 2048 + h * 128 + mp * 64, NIN, (const att::bf16*)QKV + rowbase * NIN + 2560 + h * 128, NIN,
                                                  0, 4 * qb + 4, 0, cw, q0 + wave * 32, slope2, o);
                        if (mp == 0) {
#pragma unroll
                            for (int d = 0; d < 4; ++d)
#pragma unroll
                                for (int r = 0; r < 16; ++r) stash[(d * 16 + r) * 64 + lane] = (unsigned short)(att::cvtpk(o[d][r], 0.f) & 0xffffu);
                        }
                    }
                    asm volatile("s_waitcnt lgkmcnt(0)" ::: "memory");
#pragma unroll
                    for (int r = 0; r < 16; ++r) { float ss = 0.f;
#pragma unroll
                        for (int d = 0; d < 4; ++d) { const float v = att::bf2f(stash[(d * 16 + r) * 64 + lane]) - lam * o[d][r]; o[d][r] = v; ss += v * v; }
                        ss += lane_xor<1>(ss); ss += lane_xor<2>(ss); ss += lane_xor<4>(ss); ss += lane_xor<8>(ss); ss += lane_xor<16>(ss);
                        const float rs = rsqrtf(ss * (1.f / 128.f) + EPS) * gsc;
#pragma unroll
                        for (int d = 0; d < 4; ++d) o[d][r] *= rs; }
#pragma unroll
                    for (int d = 0; d < 4; ++d) { const float gg = sg[d * 32 + r32];
#pragma unroll
                        for (int r = 0; r < 16; ++r) o[d][r] *= gg; }
                    (void)hi;
                    att::store_tile_bf16<128>(ldsg + wave * 8192, (att::bf16*)MIX + (rowbase + q0 + wave * 32) * DM + 512 + h * 128, DM, o);
                    __syncthreads();
                }
            }
            const float* const os_ = OS; bf16* const mix_ = MIX;
            for (int it = gw; it < MS * 4; it += NGW) {
                const int row = it >> 2, h = it & 3; const size_t off = (size_t)row * 512 + h * 128 + 2 * lane;
                const float2 a = *(const float2*)(os_ + off), c = *(const float2*)(os_ + (size_t)MS * 512 + off);
                const float v0 = a.x - lam * c.x, v1 = a.y - lam * c.y;
                const float rs = rsqrtf(wave_sum(v0 * v0 + v1 * v1) * (1.f / 128.f) + EPS) * gsc;
                *(unsigned*)(mix_ + (size_t)(MP + row) * DM + 512 + h * 128 + 2 * lane) = pk2(v0 * rs * sg[2 * lane], v1 * rs * sg[2 * lane + 1]);
            }
        }
        GRID_BAR();
        if (EN_WOUT_) GEMM_SPLIT(REP_OUT, MIX, WOUT + (size_t)l * DM * DM, DM, 4);
        GRID_BAR();
        THIN(false, ng + 3 * DM, 1.0f, false, 4);
        GRID_BAR();
        if (EN_WCQ_) { pg8::EpiPlain E{(pg8::bf16_t*)QC, 512, QS128, RS}; GEMM_STATIC(REP_CQ, XN, WCQ + (size_t)l * 512 * DM, 512, DM, pg8::EpiPlain, E); }
        GRID_BAR();
        for (int rep_ = 0; rep_ < REP_C; ++rep_) {
            if (rep_) GRID_BAR();
            FRESH_TID();
            for (int rsc_ = 0; rsc_ < REP_SC; ++rsc_)
            if (EN_SCROSS && vcu < SB * 4) {
                const int b = vcu >> 2, h = vcu & 3;
                const float* Kc = INP(I_CMK) + ((size_t)(l * SB + b) * NMEM) * 512 + h * 128;
                const float* Vc = INP(I_CMV) + ((size_t)(l * SB + b) * NMEM) * 512 + h * 128;
                att::small_core<128, 128, 0, 1, false>(ldsg, (const att::bf16*)QC + (size_t)(MP + b * ST) * 512 + h * 128, 512, Kc, Vc, NMEM, nullptr, nullptr, 512, 0, 0, 0, 0.f);
                const float* Osum = (const float*)(ldsg + att::SM_OSUM); const float* lsum = (const float*)(ldsg + att::SM_L);
                bf16* od = OC + (size_t)(MP + b * ST) * 512 + h * 128;
                for (int i = tid; i < 32 * 128; i += NTHREADS) { const int q = i >> 7, d = i & 127; od[(size_t)q * 512 + d] = (bf16)f2bf(Osum[d * 33 + q] / lsum[q]); }
                __syncthreads();
            }
            for (int i2 = 0; EN_PCROSS && i2 < 2 * REP_PC; ++i2) { const int i = i2 & 1;
                const int u = i * G + vcu; if (u >= PB * 4 * 16) break;
                const int bh = u >> 4, qb = u & 15, b = bh >> 2, h = bh & 3, q0 = qb * 256; const size_t rowbase = (size_t)b * PT;
                const att::bf16* Kh = (const att::bf16*)MKV + ((size_t)l * MMEM + (size_t)b * NMEM) * 1024 + h * 128;
                att::f32x16 o[4];
                att::BIGC_CROSS<128, 128, 0>(ldsg, (const att::bf16*)QC + (rowbase + q0 + wave * 32) * 512 + h * 128, 512, Kh, 1024, Kh + 512, 1024, 0, 4, 0, 3, 0, 0.f, o);
                att::store_tile_bf16<128>(ldsg + wave * 8192, (att::bf16*)OC + (rowbase + q0 + wave * 32) * 512 + h * 128, 512, o);
                __syncthreads();
            }
        }
        GRID_BAR();
        if (EN_WCO_) GEMM_SPLIT(REP_CO, OC, WCO + (size_t)l * DM * 512, 512, 2);
        GRID_BAR();
        THIN(false, ng + 5 * DM, 1.0f, false, 2);
        GRID_BAR();
        if (EN_GU2) { pg8::EpiSwiGLU E{(pg8::bf16_t*)ACT, DFF, RS}; GEMM_STATIC(REP_GU, XN, WGU + (size_t)(l * 2 + 1) * NGU * DM, NGU, DM, pg8::EpiSwiGLU, E); }
        GRID_BAR();
        if (EN_DN2) GEMM_SPLIT(REP_DN, ACT, WDN + (size_t)(l * 2 + 1) * DM * DFF, DFF, 11);
        GRID_BAR();
        THIN(false, ng + 7 * DM, 0.5f, l + 1 == DEPTH, 11);
        if (l + 1 < DEPTH) GRID_BAR();
    }
}

#undef out
#undef Y
extern "C" void kernel_launch(void* const* d_in, const int* in_sizes, int n_in, void* d_out, int out_size, void* d_ws, size_t ws_size, hipStream_t stream) {
    static int ready = 0;
    if (ready == 0) {
        if (n_in != 21 || (size_t)out_size != O_END || ws_size < WS_END) { fprintf(stderr, "kernel_launch: unexpected shapes: n_in %d out %d ws %zu\n", n_in, out_size, ws_size); ready = -1; return; }
        if (hipFuncSetAttribute((const void*)fwd_kernel, hipFuncAttributeMaxDynamicSharedMemorySize, LDS_BYTES) != hipSuccess) { fprintf(stderr, "kernel_launch: hipFuncSetAttribute failed\n"); ready = -1; return; }
        int per_cu = 0;
        if (hipOccupancyMaxActiveBlocksPerMultiprocessor(&per_cu, (const void*)fwd_kernel, NTHREADS, LDS_BYTES) != hipSuccess || per_cu < 1)
            fprintf(stderr, "kernel_launch: note: occupancy query reports %d workgroups per CU\n", per_cu);
        (void)hipGetLastError();
        ready = 1;
    }
    if (ready < 0) return;
    (void)hipMemsetAsync((char*)d_ws + WS_CTL, 0, CTL_ZERO_BYTES, stream);
    Args a{};
    for (int i = 0; i < 21; ++i) a.in[i] = (const float*)d_in[i];
    a.out = (float*)d_out; a.ws = (unsigned char*)d_ws;
    hipLaunchKernelGGL(fwd_kernel, dim3(256), dim3(NTHREADS), LDS_BYTES, stream, a);
    const hipError_t le = hipPeekAtLastError();
    if (le != hipSuccess) fprintf(stderr, "kernel_launch: launch failed: %s\n", hipGetErrorName(le));
}
```

```cpp
#include <hip/hip_runtime.h>
#include <cstdio>
#include <cstdint>

constexpr int DM = 1024, PB = 8, PT = 4096, SB = 32, ST = 32, DEPTH = 2;
constexpr int MP = PB * PT, MS = SB * ST, MTOT = MP + MS;
constexpr int DFF = 2816, NGU = 2 * DFF, NIN = 3072, NMEM = 256, MMEM = PB * NMEM, PAST = 4096, WA = 512;
constexpr float EPS = 1e-6f, LOG2E = 1.4426950408889634f;
constexpr float QS64 = 0.125f * LOG2E, QS128 = 0.08838834764831845f * LOG2E;
constexpr size_t O_Y = 0, O_PAK = (size_t)MTOT * DM, O_PAV = O_PAK + 4194304, O_PBK = O_PAV + 4194304, O_PBV = O_PBK + 33554432,
                 O_PMK = O_PBV + 33554432, O_PMV = O_PMK + 2097152, O_SAK = O_PMV + 2097152, O_SAV = O_SAK + 1048576,
                 O_SBK = O_SAV + 1048576, O_SBV = O_SBK + 1048576, O_END = O_SBV + 1048576;
static_assert(O_END == 118489088, "output size");
constexpr size_t MiB = 1u << 20;
constexpr size_t WS_CTL = 0, CTL_ZERO_BYTES = MiB;
constexpr size_t WS_WGU = 1 * MiB, WS_WDN = 45 * MiB, WS_WIN = 67 * MiB, WS_WOUT = 79 * MiB, WS_WCQ = 83 * MiB, WS_WCKV = 85 * MiB, WS_WCO = 89 * MiB;
constexpr size_t WS_XN = 92 * MiB, WS_ACT = 158 * MiB, WS_Y = 340 * MiB, WS_QKV = 406 * MiB, WS_MIX = 604 * MiB, WS_QC = 670 * MiB, WS_OC = 703 * MiB;
constexpr size_t WS_MEMN = 736 * MiB, WS_MKV = 744 * MiB, WS_OS = 752 * MiB, WS_RS = 756 * MiB, WS_YP = 757 * MiB, WS_END = 801 * MiB;
static_assert((size_t)MTOT * DFF * 2 <= WS_Y - WS_ACT && (size_t)MTOT * NIN * 2 <= WS_MIX - WS_QKV && (size_t)MTOT * DM * 2 <= WS_ACT - WS_XN, "ws map");
namespace pg8 {
#define PG8_LAS __attribute__((address_space(3)))
typedef unsigned short bf16_t;
typedef short bf16x8 __attribute__((ext_vector_type(8)));
typedef float f32x4 __attribute__((ext_vector_type(4)));
typedef unsigned u32x4 __attribute__((ext_vector_type(4)));
constexpr int BM = 256, BK = 64, HALF = 128, HTB = HALF * BK * 2  , STAGE_BYTES = 8 * HTB, NXCD = 8, WGM = 8;

__host__ __device__ __forceinline__ int lds_byte(int r, int c) { const int st = (r >> 4) * 2 + (c >> 5), rr = r & 15, cc = c & 31, ob = rr * 64 + cc * 2; return st * 1024 + (ob ^ (((ob >> 9) & 1) << 5)); }
__host__ __device__ __forceinline__ void stage_rc(int b, int& R, int& C) { const int st = b / 1024, sb = b % 1024, swz = sb ^ (((sb >> 9) & 1) << 5); R = (st >> 1) * 16 + swz / 64; C = (st & 1) * 32 + (swz % 64) / 2; }
__host__ __device__ __forceinline__ int perm32(int rho) { const int n = rho >> 4, i = rho & 15; return 8 * (i >> 2) + 4 * n + (i & 3); }

struct Unit { int pm, pn, pk; };
struct Gemm { const bf16_t* A; const bf16_t* Bt; int M, N, K, Kc; };

struct StaticOrder {
    int nM, nN, nwg, G, c;
    __host__ __device__ void init(int M, int N, int G_, int c_) { nM = M / BM; nN = N / BM; nwg = nM * nN; G = G_; c = c_; }
    __host__ __device__ bool next(int i, Unit& u) const {
        const long L = (long)i * G + c; if (L >= nwg) return false;
        int wgid = (int)L; { const int q = nwg / NXCD, r = nwg % NXCD, xcd = wgid % NXCD, off = wgid / NXCD; wgid = (xcd < r ? xcd * (q + 1) : r * (q + 1) + (xcd - r) * q) + off; }
        const int nig = WGM * nN, gid = wgid / nig, fm = gid * WGM, gsz = (nM - fm) < WGM ? (nM - fm) : WGM;
        u.pm = fm + ((wgid % nig) % gsz); u.pn = (wgid % nig) / gsz; u.pk = 0; return true;
    }
    __device__ __forceinline__ void a_ready(const Unit&) const {}
    __device__ __forceinline__ void done(const Unit&) const {}
};

typedef float f32x2_cv __attribute__((ext_vector_type(2))); typedef __bf16 bf16x2_cv __attribute__((ext_vector_type(2)));
__device__ __forceinline__ unsigned cvt_pk_bf16(float lo, float hi) { const f32x2_cv v = {lo, hi}; const bf16x2_cv b = __builtin_convertvector(v, bf16x2_cv); return __builtin_bit_cast(unsigned, b); }
typedef float f32x2 __attribute__((ext_vector_type(2)));

struct SubsetOrder {
    int nN, nwg, G, c;
    __device__ __forceinline__ void init(int nM_, int nN_, int G_, int c_) { nN = nN_; nwg = nM_ * nN_; G = G_; c = c_; }
    __device__ __forceinline__ bool next(int i, Unit& u) const {
        if (c < 0 || c >= G) return false;
        const long L = (long)i * G + c; if (L >= nwg) return false;
        u.pm = (int)L / nN; u.pn = (int)L % nN; u.pk = 0; return true;
    }
    __device__ __forceinline__ void a_ready(const Unit&) const {}
    __device__ __forceinline__ void done(const Unit&) const {}
};

struct SplitOrder {
    int nN, SK, nwg, G, c, pm0;
    __device__ __forceinline__ void init(int pm0_, int nM_, int nN_, int SK_, int G_, int c_) { pm0 = pm0_; nN = nN_; SK = SK_; nwg = nM_ * nN_ * SK_; G = G_; c = c_; }
    __device__ __forceinline__ bool next(int i, Unit& u) const {
        const long L = (long)i * G + c; if (L >= nwg) return false;
        u.pk = (int)L % SK; const int t = (int)L / SK; u.pn = t % nN; u.pm = pm0 + t / nN; return true;
    }
    __device__ __forceinline__ void a_ready(const Unit&) const {}
    __device__ __forceinline__ void done(const Unit&) const {}
};
__device__ __forceinline__ u32x4 pack8(f32x4 v0, f32x4 v1) { u32x4 w; w.x = cvt_pk_bf16(v0[0], v0[1]); w.y = cvt_pk_bf16(v0[2], v0[3]); w.z = cvt_pk_bf16(v1[0], v1[1]); w.w = cvt_pk_bf16(v1[2], v1[3]); return w; }
struct EpiPlain {
    static constexpr bool PERM = true, AFTER_DRAIN = false;
    bf16_t* O; int ldo; float scale; const float* rs;
    __device__ __forceinline__ void operator()(const f32x4 (&acc)[2][2][4][2], const Unit& u, int wr, int wc, int fr, int fq) const {
        const bf16_t* base = O + (size_t)u.pm * BM * ldo + (size_t)u.pn * BM;
        const unsigned offB = (unsigned)((wr * 64 + fr) * ldo + wc * 32 + 8 * fq) * 2u, roff = (unsigned)(wr * 64 + fr) * 4u;
        float scv[2][4];
        if (rs) { const float* rsb = rs + (size_t)u.pm * BM;
#pragma unroll
            for (int ai = 0; ai < 2; ++ai)
#pragma unroll
                for (int m = 0; m < 4; ++m) scv[ai][m] = *(const float*)((const char*)(rsb + ai * HALF + m * 16) + roff);
#pragma unroll
            for (int ai = 0; ai < 2; ++ai)
#pragma unroll
                for (int m = 0; m < 4; ++m) scv[ai][m] *= scale; }
        else {
#pragma unroll
            for (int ai = 0; ai < 2; ++ai)
#pragma unroll
                for (int m = 0; m < 4; ++m) scv[ai][m] = scale; }
#pragma unroll
        for (int ai = 0; ai < 2; ++ai)
#pragma unroll
            for (int m = 0; m < 4; ++m) { char* rowp = (char*)(base + (size_t)(ai * HALF + m * 16) * ldo) + offB;
                const float sc = scv[ai][m];
#pragma unroll
                for (int bj = 0; bj < 2; ++bj) *(u32x4*)(rowp + bj * HALF * 2) = pack8(acc[ai][bj][m][0] * sc, acc[ai][bj][m][1] * sc); }
    }
};
__device__ __forceinline__ float silu_mul(float g, float u) { return g * __builtin_amdgcn_rcpf(1.0f + __builtin_amdgcn_exp2f(-1.4426950408889634f * g)) * u; }
struct EpiPartial {
    static constexpr bool PERM = true, AFTER_DRAIN = false;
    float* P; int ldp, row_base; size_t slab;
    __device__ __forceinline__ void operator()(const f32x4 (&acc)[2][2][4][2], const Unit& u, int wr, int wc, int fr, int fq) const {
        const float* base = P + (size_t)u.pk * slab + ((size_t)(u.pm * BM - row_base) * ldp + (size_t)u.pn * BM);
        const unsigned offB = (unsigned)((wr * 64 + fr) * ldp + wc * 32 + 8 * fq) * 4u;
#pragma unroll
        for (int ai = 0; ai < 2; ++ai)
#pragma unroll
            for (int m = 0; m < 4; ++m) { char* rowp = (char*)(base + (size_t)(ai * HALF + m * 16) * ldp) + offB;
#pragma unroll
                for (int bj = 0; bj < 2; ++bj) { *(f32x4*)(rowp + bj * HALF * 4) = acc[ai][bj][m][0]; *(f32x4*)(rowp + bj * HALF * 4 + 16) = acc[ai][bj][m][1]; } }
    }
};
struct EpiSwiGLU {
    static constexpr bool PERM = true, AFTER_DRAIN = false;
    bf16_t* O; int ldo; const float* rs;
    __device__ __forceinline__ void operator()(const f32x4 (&acc)[2][2][4][2], const Unit& u, int wr, int wc, int fr, int fq) const {
        const bf16_t* base = O + (size_t)u.pm * BM * ldo + (size_t)u.pn * HALF;
        const unsigned offB = (unsigned)((wr * 64 + fr) * ldo + wc * 32 + 8 * fq) * 2u, roff = (unsigned)(wr * 64 + fr) * 4u;
        const float* rsb = rs + (size_t)u.pm * BM;
        float scv[2][4];
#pragma unroll
        for (int ai = 0; ai < 2; ++ai)
#pragma unroll
            for (int m = 0; m < 4; ++m) scv[ai][m] = *(const float*)((const char*)(rsb + ai * HALF + m * 16) + roff);
        asm volatile("" : "+v"(scv[0][0]), "+v"(scv[0][1]), "+v"(scv[0][2]), "+v"(scv[0][3]), "+v"(scv[1][0]), "+v"(scv[1][1]), "+v"(scv[1][2]), "+v"(scv[1][3]));
#pragma unroll
        for (int ai = 0; ai < 2; ++ai)
#pragma unroll
            for (int m = 0; m < 4; ++m) { char* rowp = (char*)(base + (size_t)(ai * HALF + m * 16) * ldo) + offB;
                const float sc = scv[ai][m];
                f32x4 a0, a1;
#pragma unroll
                for (int e = 0; e < 4; ++e) { a0[e] = silu_mul(acc[ai][0][m][0][e] * sc, acc[ai][1][m][0][e] * sc); a1[e] = silu_mul(acc[ai][0][m][1][e] * sc, acc[ai][1][m][1][e] * sc); }
                *(u32x4*)rowp = pack8(a0, a1); }
    }
};
struct EpiQKV {
    static constexpr bool PERM = true, AFTER_DRAIN = false;
    bf16_t* QKV; float* out; int layer; const float* rs;
    __device__ __forceinline__ void operator()(const f32x4 (&acc)[2][2][4][2], const Unit& u, int wr, int wc, int fr, int fq) const {
        const int seg = u.pn >> 1, hf = u.pn & 1;
        const float scale = (seg == 0 || seg == 3) ? QS64 : 1.0f;
        const int rl0 = wr * 64 + fr;
        const int colq = u.pn * BM + wc * 32 + 8 * fq, cs = hf * BM + wc * 32 + 8 * fq;
        float* sbase = nullptr;
        if (seg == 1 || seg == 2 || seg == 4 || seg == 5) {
            if (u.pm < MP / BM) {
                if (seg >= 4) sbase = out + (seg == 4 ? O_PBK : O_PBV) + ((size_t)layer * MP + (size_t)u.pm * BM) * 512;
                else if ((u.pm & 15) >= 14) sbase = out + (seg == 1 ? O_PAK : O_PAV) + ((size_t)(layer * PB + (u.pm >> 4)) * WA + (size_t)((u.pm & 15) - 14) * BM) * 512;
            } else {
                const size_t o = seg == 1 ? O_SAK : seg == 2 ? O_SAV : seg == 4 ? O_SBK : O_SBV;
                sbase = out + o + ((size_t)layer * MS + (size_t)(u.pm - MP / BM) * BM) * 512;
            }
        }
        const bf16_t* qbase = QKV + (size_t)u.pm * BM * NIN + (size_t)u.pn * BM;
        const unsigned offB = (unsigned)(rl0 * NIN + wc * 32 + 8 * fq) * 2u, roff = (unsigned)rl0 * 4u;
        const float* rsb = rs + (size_t)u.pm * BM;
        float scv[2][4];
#pragma unroll
        for (int ai = 0; ai < 2; ++ai)
#pragma unroll
            for (int m = 0; m < 4; ++m) scv[ai][m] = *(const float*)((const char*)(rsb + ai * HALF + m * 16) + roff);
#pragma unroll
        for (int ai = 0; ai < 2; ++ai)
#pragma unroll
            for (int m = 0; m < 4; ++m) { char* rowp = (char*)(qbase + (size_t)(ai * HALF + m * 16) * NIN) + offB; const float sc = scv[ai][m] * scale;
#pragma unroll
                for (int bj = 0; bj < 2; ++bj) *(u32x4*)(rowp + bj * HALF * 2) = pack8(acc[ai][bj][m][0] * sc, acc[ai][bj][m][1] * sc); }
        if (sbase) {
            const unsigned soffB = (unsigned)(rl0 * 512 + cs) * 4u;
#pragma unroll
            for (int ai = 0; ai < 2; ++ai)
#pragma unroll
                for (int m = 0; m < 4; ++m) { char* sp = (char*)(sbase + (size_t)(ai * HALF + m * 16) * 512) + soffB; const float sc = scv[ai][m];
#pragma unroll
                    for (int bj = 0; bj < 2; ++bj) { *(f32x4*)(sp + bj * HALF * 4) = acc[ai][bj][m][0] * sc; *(f32x4*)(sp + bj * HALF * 4 + 16) = acc[ai][bj][m][1] * sc; } }
        }
    }
};
struct EpiMemKV {
    static constexpr bool PERM = true, AFTER_DRAIN = false;
    bf16_t* MKV; float* out; int layer;
    __device__ __forceinline__ void operator()(const f32x4 (&acc)[2][2][4][2], const Unit& u, int wr, int wc, int fr, int fq) const {
        const int row0 = u.pm * BM + wr * 64 + fr, col0 = u.pn * BM + wc * 32 + 8 * fq, cs = (u.pn & 1) * BM + wc * 32 + 8 * fq;
        float* sbase = out + (u.pn < 2 ? O_PMK : O_PMV) + (size_t)layer * MMEM * 512;
#pragma unroll
        for (int ai = 0; ai < 2; ++ai)
#pragma unroll
            for (int m = 0; m < 4; ++m) { const int row = row0 + ai * HALF + m * 16; bf16_t* rowp = MKV + (size_t)row * 1024 + col0;
#pragma unroll
                for (int bj = 0; bj < 2; ++bj) { *(u32x4*)(rowp + bj * HALF) = pack8(acc[ai][bj][m][0], acc[ai][bj][m][1]);
                    float* sp = sbase + (size_t)row * 512 + cs + bj * HALF; *(f32x4*)sp = acc[ai][bj][m][0]; *(f32x4*)(sp + 4) = acc[ai][bj][m][1]; } }
    }
};
template <class Epi, class Sched, bool ALIGN_EPI = false, bool SP2 = false>
__device__ __forceinline__ void gemm_phase(PG8_LAS unsigned char* lds, const Gemm g, const Sched& S, const Epi& E) {
    int tid = threadIdx.x; asm volatile("" : "+v"(tid));
    const int wid = __builtin_amdgcn_readfirstlane(tid >> 6), lane = tid & 63, wr = wid >> 2, wc = wid & 3, fr = lane & 15, fq = lane >> 4;
    const int K = g.K, KL = g.Kc ? g.Kc : g.K, nt = KL / BK;
    unsigned voffA[2], voffB[2];
#pragma unroll
    for (int i = 0; i < 2; ++i) { int R, C; stage_rc(tid * 16 + i * 8192, R, C); const int Rb = Epi::PERM ? ((R & ~31) + perm32(R & 31)) : R;
        voffA[i] = (unsigned)(R * K + C) * 2u; voffB[i] = (unsigned)(Rb * K + C) * 2u; }
    const size_t kstep = (size_t)(BK * 2);
    const size_t hstep = (size_t)HALF * K * 2;
    const size_t tstep = 2 * hstep;
    const unsigned ldsw = (unsigned)wid * 1024u;
    const int aoff = lds_byte(wr * 64 + fr, fq * 8), boff = lds_byte(wc * 32 + fr, fq * 8);
#define PG8_SA(b, h) (((b) * 2 + (h)) * HTB)
#define PG8_SB(b, h) ((4 + (b) * 2 + (h)) * HTB)
#define PG8_STAGE(bufoff, gbase, voff) do { _Pragma("unroll") for (int _i = 0; _i < 2; ++_i) \
        __builtin_amdgcn_global_load_lds((const unsigned*)((const char*)(gbase) + (voff)[_i]), (PG8_LAS unsigned*)(lds + (bufoff) + ldsw + _i * 8192), 16, 0, 0); } while (0)
#define PG8_LDA(dst, b, h) do { _Pragma("unroll") for (int m = 0; m < 4; ++m) _Pragma("unroll") for (int k = 0; k < 2; ++k) dst[m][k] = *(const PG8_LAS bf16x8*)(lds + PG8_SA(b, h) + aoff + m * 2048 + k * 1024); } while (0)
#define PG8_LDB(dst, b, h) do { _Pragma("unroll") for (int n = 0; n < 2; ++n) _Pragma("unroll") for (int k = 0; k < 2; ++k) dst[n][k] = *(const PG8_LAS bf16x8*)(lds + PG8_SB(b, h) + boff + n * 2048 + k * 1024); } while (0)
#define PG8_MMA(ai, bj, At, Bt) do { __builtin_amdgcn_s_setprio(1); _Pragma("unroll") for (int m = 0; m < 4; ++m) _Pragma("unroll") for (int n = 0; n < 2; ++n) _Pragma("unroll") for (int k = 0; k < 2; ++k) \
        acc[ai][bj][m][n] = __builtin_amdgcn_mfma_f32_16x16x32_bf16(Bt[n][k], At[m][k], acc[ai][bj][m][n], 0, 0, 0); __builtin_amdgcn_s_setprio(0); } while (0)
#define PG8_WAIT_V(n) asm volatile("s_waitcnt vmcnt(" #n ")" ::: "memory")
#define PG8_WAIT_L(n) asm volatile("s_waitcnt lgkmcnt(" #n ")" ::: "memory")
#define PG8_BAR __builtin_amdgcn_s_barrier()
#define PG8_SCHED __builtin_amdgcn_sched_barrier(0)
    Unit cur, nxt; int ui = 0;
    if (!S.next(0, cur)) return;
    f32x4 acc[2][2][4][2];
#pragma unroll
    for (int a = 0; a < 2; ++a)
#pragma unroll
        for (int b = 0; b < 2; ++b)
#pragma unroll
            for (int m = 0; m < 4; ++m)
#pragma unroll
                for (int n = 0; n < 2; ++n) acc[a][b][m][n] = (f32x4){0.f, 0.f, 0.f, 0.f};
    bf16x8 At[4][2], B0[2][2], B1[2][2];
    const char* cA = (const char*)g.A + (size_t)cur.pm * tstep + (size_t)cur.pk * KL * 2; const char* cB = (const char*)g.Bt + (size_t)cur.pn * tstep + (size_t)cur.pk * KL * 2;
    S.a_ready(cur);
    if constexpr (SP2) {
        PG8_STAGE(PG8_SB(0, 0), cB, voffB); PG8_STAGE(PG8_SB(0, 1), cB + hstep, voffB); PG8_STAGE(PG8_SA(0, 0), cA, voffA); PG8_STAGE(PG8_SA(0, 1), cA + hstep, voffA);
        if (wr == 1) PG8_BAR;
        PG8_WAIT_V(2); PG8_BAR;
        PG8_STAGE(PG8_SB(1, 0), cB + kstep, voffB); PG8_STAGE(PG8_SA(1, 0), cA + kstep, voffA); PG8_STAGE(PG8_SB(1, 1), cB + hstep + kstep, voffB);
        PG8_WAIT_V(6); PG8_BAR;
    } else {
        PG8_STAGE(PG8_SB(0, 0), cB, voffB); PG8_STAGE(PG8_SA(0, 0), cA, voffA); PG8_STAGE(PG8_SB(0, 1), cB + hstep, voffB); PG8_STAGE(PG8_SA(0, 1), cA + hstep, voffA);
        if (wr == 1) PG8_BAR;
        PG8_WAIT_V(4); PG8_BAR;
        PG8_STAGE(PG8_SB(1, 0), cB + kstep, voffB); PG8_STAGE(PG8_SA(1, 0), cA + kstep, voffA); PG8_STAGE(PG8_SB(1, 1), cB + hstep + kstep, voffB);
        PG8_WAIT_V(6); PG8_BAR;
    }
    for (;;) {
        const bool has_next = S.next(ui + 1, nxt);
        const char* nA = has_next ? (const char*)g.A + (size_t)nxt.pm * tstep + (size_t)nxt.pk * KL * 2 : cA; const char* nB = has_next ? (const char*)g.Bt + (size_t)nxt.pn * tstep + (size_t)nxt.pk * KL * 2 : cB;
        for (int t = 0; t < nt; t += 2) {
            const bool last = (t == nt - 2);
            const char* a1 = cA + (size_t)(t + 1) * kstep;
            const char* a2 = last ? nA : cA + (size_t)(t + 2) * kstep; const char* b2 = last ? nB : cB + (size_t)(t + 2) * kstep;
            const char* a3 = a2 + kstep; const char* b3 = b2 + kstep;
            if (last && has_next) S.a_ready(nxt);
            if constexpr (SP2) {
            PG8_LDB(B0, 0, 0); PG8_LDB(B1, 0, 1); PG8_SCHED; PG8_LDA(At, 0, 0); PG8_STAGE(PG8_SA(1, 1), a1 + hstep, voffA);
            PG8_WAIT_V(8); PG8_WAIT_L(0); PG8_BAR; PG8_MMA(0, 0, At, B0); PG8_MMA(0, 1, At, B1); PG8_BAR; PG8_SCHED;
            PG8_LDA(At, 0, 1); PG8_STAGE(PG8_SB(0, 0), b2, voffB); PG8_STAGE(PG8_SB(0, 1), b2 + hstep, voffB); PG8_STAGE(PG8_SA(0, 0), a2, voffA);
            PG8_WAIT_V(8); PG8_WAIT_L(0); PG8_BAR; PG8_MMA(1, 0, At, B0); PG8_MMA(1, 1, At, B1); PG8_BAR; PG8_SCHED;
            PG8_LDB(B0, 1, 0); PG8_LDB(B1, 1, 1); PG8_SCHED; PG8_LDA(At, 1, 0); PG8_STAGE(PG8_SA(0, 1), a2 + hstep, voffA);
            PG8_WAIT_V(8); PG8_WAIT_L(0); PG8_BAR; PG8_MMA(0, 0, At, B0); PG8_MMA(0, 1, At, B1); PG8_BAR; PG8_SCHED;
            PG8_LDA(At, 1, 1); PG8_STAGE(PG8_SB(1, 0), b3, voffB); PG8_STAGE(PG8_SB(1, 1), b3 + hstep, voffB); PG8_STAGE(PG8_SA(1, 0), a3, voffA);
            PG8_WAIT_V(8); PG8_WAIT_L(0); PG8_BAR; PG8_MMA(1, 0, At, B0); PG8_MMA(1, 1, At, B1); PG8_BAR; PG8_SCHED;
            } else {
            PG8_LDB(B0, 0, 0); PG8_SCHED; PG8_LDA(At, 0, 0); PG8_STAGE(PG8_SA(1, 1), a1 + hstep, voffA);
            PG8_WAIT_L(8); PG8_BAR; PG8_WAIT_L(0); PG8_MMA(0, 0, At, B0); PG8_BAR; PG8_SCHED;
            PG8_LDB(B1, 0, 1); PG8_STAGE(PG8_SB(0, 0), b2, voffB);
            PG8_BAR; PG8_WAIT_L(0); PG8_MMA(0, 1, At, B1); PG8_BAR;
            PG8_LDA(At, 0, 1); PG8_STAGE(PG8_SA(0, 0), a2, voffA);
            PG8_BAR; PG8_WAIT_L(0); PG8_MMA(1, 0, At, B0); PG8_BAR; PG8_SCHED;
            PG8_STAGE(PG8_SB(0, 1), b2 + hstep, voffB);
            PG8_WAIT_V(6); PG8_BAR; PG8_MMA(1, 1, At, B1); PG8_BAR;
            PG8_LDB(B0, 1, 0); PG8_SCHED; PG8_LDA(At, 1, 0); PG8_STAGE(PG8_SA(0, 1), a2 + hstep, voffA);
            PG8_WAIT_L(8); PG8_BAR; PG8_WAIT_L(0); PG8_MMA(0, 0, At, B0); PG8_BAR; PG8_SCHED;
            PG8_LDB(B1, 1, 1); PG8_STAGE(PG8_SB(1, 0), b3, voffB);
            PG8_BAR; PG8_WAIT_L(0); PG8_MMA(0, 1, At, B1); PG8_BAR;
            PG8_LDA(At, 1, 1); PG8_STAGE(PG8_SA(1, 0), a3, voffA);
            PG8_BAR; PG8_WAIT_L(0); PG8_MMA(1, 0, At, B0); PG8_BAR; PG8_SCHED;
            PG8_STAGE(PG8_SB(1, 1), b3 + hstep, voffB);
            PG8_WAIT_V(6); PG8_BAR; PG8_MMA(1, 1, At, B1); PG8_BAR;
            }
        }
        if constexpr (ALIGN_EPI) { if (wr == 0) PG8_BAR; }
        if constexpr (!Epi::AFTER_DRAIN) { E(acc, cur, wr, wc, fr, fq); S.done(cur); }
        if (!has_next) break;
#pragma unroll
        for (int a = 0; a < 2; ++a)
#pragma unroll
            for (int b = 0; b < 2; ++b)
#pragma unroll
                for (int m = 0; m < 4; ++m)
#pragma unroll
                    for (int n = 0; n < 2; ++n) acc[a][b][m][n] = (f32x4){0.f, 0.f, 0.f, 0.f};
        cur = nxt; cA = nA; cB = nB; ++ui;
        if constexpr (ALIGN_EPI) { if (wr == 1) PG8_BAR; }
    }
    PG8_WAIT_V(0);
    if constexpr (!ALIGN_EPI) { if (wr == 0) PG8_BAR; }
    PG8_BAR;
    if constexpr (Epi::AFTER_DRAIN) { E.fused(acc, cur, wr, wc, fr, fq, lds, wid, lane); S.done(cur); }
#undef PG8_SA
#undef PG8_SB
#undef PG8_STAGE
#undef PG8_LDA
#undef PG8_LDB
#undef PG8_MMA
#undef PG8_WAIT_V
#undef PG8_WAIT_L
#undef PG8_BAR
#undef PG8_SCHED
}
}
namespace att {
typedef unsigned short bf16;
using bf16x8 = __attribute__((ext_vector_type(8))) short;
using s16x4  = __attribute__((ext_vector_type(4))) short;
using f32x16 = __attribute__((ext_vector_type(16))) float;
using f32x4  = __attribute__((ext_vector_type(4))) float;
using u32x4  = __attribute__((ext_vector_type(4))) unsigned;
using u32x2  = __attribute__((ext_vector_type(2))) unsigned;
#define KSWZ(row, colB) ((row) * 256 + ((colB) ^ (((row) & 7) << 4)))
#define SBAR() __builtin_amdgcn_sched_barrier(0)
constexpr int L_K = 0, L_V = 32768, L_WS = 65536, L_TAB = 67584, L_STASH = 69632, L_END = L_STASH + 65536;
constexpr int SM_SLAB = 128 * 33 * 4, SM_OSUM = 0, SM_L = 8 * SM_SLAB, SM_LP = SM_L + 128, SM_M = SM_LP + 1024;
static_assert(SM_M + 1024 <= 139264, "small-body LDS map");
__device__ __forceinline__ int crow(int r, int hi) { return (r & 3) + 8 * (r >> 2) + 4 * hi; }
typedef float f32x2_cv __attribute__((ext_vector_type(2))); typedef __bf16 bf16x2_cv __attribute__((ext_vector_type(2)));
__device__ __forceinline__ unsigned cvtpk(float lo, float hi) { const f32x2_cv v = {lo, hi}; const bf16x2_cv b = __builtin_convertvector(v, bf16x2_cv); return __builtin_bit_cast(unsigned, b); }
__device__ __forceinline__ float bf2f(unsigned short h) { return __uint_as_float(((unsigned)h) << 16); }
__device__ __forceinline__ float ex2(float x) { return __builtin_amdgcn_exp2f(x); }
__device__ __forceinline__ float swapmax(float v) { auto rr = __builtin_amdgcn_permlane32_swap(__float_as_uint(v), __float_as_uint(v), false, false); return fmaxf(__uint_as_float(rr[0]), __uint_as_float(rr[1])); }
__device__ __forceinline__ float swapsum(float v) { auto rr = __builtin_amdgcn_permlane32_swap(__float_as_uint(v), __float_as_uint(v), false, false); return __uint_as_float(rr[0]) + __uint_as_float(rr[1]); }
__device__ __forceinline__ int v_st(int k, int c) { const int kk = (k & ~0xC) | ((k & 4) << 1) | ((k & 8) >> 1); return ((kk >> 3) * 4 + (c >> 5)) * 512 + ((kk & 7) * 32 + (c & 31)) * 2; }
__device__ __forceinline__ int v_rd_base(int lane) { return ((lane & 3) << 3) | (((lane >> 2) & 3) << 6) | (((lane >> 4) & 1) << 5) | (((lane >> 5) & 1) << 8); }
constexpr int v_rd_off(int d0, int ks, int half) { return d0 * 512 + ks * 4096 + half * 2048; }
template <int OFF> __device__ __forceinline__ s16x4 tr_read(int vb) { s16x4 r; asm volatile("ds_read_b64_tr_b16 %0, %1 offset:%2" : "=&v"(r) : "v"(vb), "i"(OFF) : "memory"); return r; }
template <int D0> __device__ __forceinline__ void pv_one(f32x16& od, int vb, bf16x8 pa0, bf16x8 pa1, bf16x8 pa2, bf16x8 pa3) {
  const s16x4 l0 = tr_read<v_rd_off(D0, 0, 0)>(vb), h0 = tr_read<v_rd_off(D0, 0, 1)>(vb), l1 = tr_read<v_rd_off(D0, 1, 0)>(vb), h1 = tr_read<v_rd_off(D0, 1, 1)>(vb);
  const s16x4 l2 = tr_read<v_rd_off(D0, 2, 0)>(vb), h2 = tr_read<v_rd_off(D0, 2, 1)>(vb), l3 = tr_read<v_rd_off(D0, 3, 0)>(vb), h3 = tr_read<v_rd_off(D0, 3, 1)>(vb);
  asm volatile("s_waitcnt lgkmcnt(0)" ::: "memory"); SBAR();
#define PK(L, H) (bf16x8){L[0], L[1], L[2], L[3], H[0], H[1], H[2], H[3]}
  od = __builtin_amdgcn_mfma_f32_32x32x16_bf16(pa0, PK(l0, h0), od, 0, 0, 0);
  od = __builtin_amdgcn_mfma_f32_32x32x16_bf16(pa1, PK(l1, h1), od, 0, 0, 0);
  od = __builtin_amdgcn_mfma_f32_32x32x16_bf16(pa2, PK(l2, h2), od, 0, 0, 0);
  od = __builtin_amdgcn_mfma_f32_32x32x16_bf16(pa3, PK(l3, h3), od, 0, 0, 0);
#undef PK
}
#define PK4(P, BASE, OUT) do { unsigned a0 = cvtpk(P[BASE + 0], P[BASE + 1]), a1 = cvtpk(P[BASE + 2], P[BASE + 3]);   \
    unsigned b0 = cvtpk(P[BASE + 4], P[BASE + 5]), b1 = cvtpk(P[BASE + 6], P[BASE + 7]);                              \
    auto r0 = __builtin_amdgcn_permlane32_swap(a0, b0, false, false); auto r1 = __builtin_amdgcn_permlane32_swap(a1, b1, false, false); \
    u32x4 w = {r0[0], r1[0], r0[1], r1[1]}; OUT = *reinterpret_cast<bf16x8*>(&w); } while (0)

template <int DQK, int DV, int MODE>
__device__ __forceinline__ void big_core(char* lds, const bf16* __restrict__ Qw, int ldq, const bf16* __restrict__ Kh, int ldk, const bf16* __restrict__ Vh, int ldv,
                                         int t_lo, int t_hi, int vis_lo, int vis_hi, int qpos_w, float slope2, f32x16 (&o)[DV / 32]) {
  int tid = threadIdx.x; asm volatile("" : "+v"(tid));
  const int wid = __builtin_amdgcn_readfirstlane(tid >> 6), lane = tid & 63, r32 = lane & 31, hi = lane >> 5;
  char* K_lds = lds + L_K; char* V_lds = lds + L_V;
  float* al_l = (float*)(lds + L_WS) + wid * 64; float* li_l = al_l + 32;
  const float* tab = (const float*)(lds + L_TAB);
  constexpr int NQ = DQK / 16, NO = DV / 32, NKL = DQK / 64, NVL = DV / 64, CPRK = DQK / 8, CPRV = DV / 8;
  bf16x8 qr[NQ];
#pragma unroll
  for (int d0 = 0; d0 < NQ; ++d0) qr[d0] = *reinterpret_cast<const bf16x8*>(Qw + (long)r32 * ldq + d0 * 16 + hi * 8);
#pragma unroll
  for (int d = 0; d < NO; ++d) o[d] = f32x16{};
  float m_reg = -1e30f, l_reg = 0.f;
  const int vb0 = (int)(uintptr_t)V_lds + v_rd_base(lane);
  bf16x8 ks_[NKL], vs_[NVL];
  bf16x8 qx = bf16x8{}, kx0 = bf16x8{}, kx1 = bf16x8{};
  if constexpr (MODE == 2) {
    if (hi == 0) {
      u32x4 wq = {0x3F803F80u, 0x00003F80u, 0u, 0u}; qx = *reinterpret_cast<bf16x8*>(&wq);
      const float v0 = slope2 * (float)r32, v1 = slope2 * (float)(32 + r32);
      const unsigned a1 = cvtpk(v0, 0.f) & 0xffffu; const float r1 = v0 - __uint_as_float(a1 << 16); const unsigned a2 = cvtpk(r1, 0.f) & 0xffffu; const float r2 = r1 - __uint_as_float(a2 << 16); const unsigned a3 = cvtpk(r2, 0.f) & 0xffffu;
      const unsigned b1 = cvtpk(v1, 0.f) & 0xffffu; const float s1 = v1 - __uint_as_float(b1 << 16); const unsigned b2 = cvtpk(s1, 0.f) & 0xffffu; const float s2 = s1 - __uint_as_float(b2 << 16); const unsigned b3 = cvtpk(s2, 0.f) & 0xffffu;
      u32x4 wa = {a1 | (a2 << 16), a3, 0u, 0u}, wb = {b1 | (b2 << 16), b3, 0u, 0u}; kx0 = *reinterpret_cast<bf16x8*>(&wa); kx1 = *reinterpret_cast<bf16x8*>(&wb);
    }
  }
#define SLOAD(t) do { _Pragma("unroll") for (int i = 0; i < NKL; ++i) { const int c = tid + 512 * i; ks_[i] = *reinterpret_cast<const bf16x8*>(Kh + (long)((t) * 64 + c / CPRK) * ldk + (c % CPRK) * 8); } \
                      _Pragma("unroll") for (int i = 0; i < NVL; ++i) { const int c = tid + 512 * i; vs_[i] = *reinterpret_cast<const bf16x8*>(Vh + (long)((t) * 64 + c / CPRV) * ldv + (c % CPRV) * 8); } } while (0)
#define SWRITE(b) do { _Pragma("unroll") for (int i = 0; i < NKL; ++i) { const int c = tid + 512 * i; *reinterpret_cast<bf16x8*>(K_lds + (b) * 16384 + KSWZ(c / CPRK, (c % CPRK) * 16)) = ks_[i]; } \
                       _Pragma("unroll") for (int i = 0; i < NVL; ++i) { const int c = tid + 512 * i; *reinterpret_cast<bf16x8*>(V_lds + (b) * 16384 + v_st(c / CPRV, (c % CPRV) * 8)) = vs_[i]; } } while (0)
  constexpr bool REV = (MODE == 2);
  const int NTL = t_hi - t_lo, t_first = REV ? t_hi - 1 : t_lo, t_step = REV ? -1 : 1;
  SLOAD(t_first); SWRITE(0); __syncthreads();
  for (int it = 0; it < NTL; ++it) {
    const int t = t_first + it * t_step;
    const int cur = it & 1;
    const bool more = (it + 1 < NTL);
    if (more) SLOAD(t + t_step);
    if (t >= vis_lo && t <= vis_hi) {
      bool continue_tile = false;
      const char* Ks = K_lds + cur * 16384;
      const int rel0 = qpos_w + r32 - t * 64;
      f32x16 p0, p1;
      bool lookup = false;
      if (MODE == 1) { lookup = (qpos_w - (t * 64 + 63)) < 128; const float c = lookup ? 0.f : tab[256];
#pragma unroll
        for (int r = 0; r < 16; ++r) { p0[r] = c; p1[r] = c; } }
      else if (MODE == 2) { p0 = __builtin_amdgcn_mfma_f32_32x32x16_bf16(kx0, qx, f32x16{}, 0, 0, 0); p1 = __builtin_amdgcn_mfma_f32_32x32x16_bf16(kx1, qx, f32x16{}, 0, 0, 0); }
      else { p0 = f32x16{}; p1 = f32x16{}; }
#pragma unroll
      for (int dg = 0; dg < NQ; dg += 4) { bf16x8 kfa[4], kfb[4];
#pragma unroll
        for (int d0 = 0; d0 < 4; ++d0) { const int cb = ((dg + d0) * 16 + hi * 8) * 2;
          kfa[d0] = *reinterpret_cast<const bf16x8*>(Ks + KSWZ(r32, cb)); kfb[d0] = *reinterpret_cast<const bf16x8*>(Ks + KSWZ(32 + r32, cb)); }
        asm volatile("s_waitcnt lgkmcnt(0)" ::: "memory"); SBAR();
#pragma unroll
        for (int d0 = 0; d0 < 4; ++d0) { p0 = __builtin_amdgcn_mfma_f32_32x32x16_bf16(kfa[d0], qr[dg + d0], p0, 0, 0, 0); p1 = __builtin_amdgcn_mfma_f32_32x32x16_bf16(kfb[d0], qr[dg + d0], p1, 0, 0, 0); }
        SBAR(); }
      if (MODE == 1) { if (lookup) {
#pragma unroll
          for (int r = 0; r < 16; ++r) { const int i0 = min(rel0 - crow(r, hi), 128) + 128, i1 = min(rel0 - crow(r, hi) - 32, 128) + 128; p0[r] += tab[i0]; p1[r] += tab[i1]; } } }
      float Tt = 0.f;
      if (MODE == 2) { Tt = slope2 * (float)(t * 64);
        if (t == vis_hi) {
          asm volatile("; own-chunk ALiBi fix-up (a real branch: not to be if-converted)" ::: "memory");
          const float r0f = (float)(rel0 - 4 * hi), s2 = 2.f * slope2;
#pragma unroll
          for (int r = 0; r < 16; ++r) { const float c0 = (float)((r & 3) + 8 * (r >> 2)); p0[r] += s2 * fminf(r0f - c0, 0.f); p1[r] += s2 * fminf(r0f - c0 - 32.f, 0.f); } } }
      float pmax = p0[0];
#pragma unroll
      for (int r = 1; r < 16; ++r) pmax = fmaxf(pmax, p0[r]);
#pragma unroll
      for (int r = 0; r < 16; ++r) pmax = fmaxf(pmax, p1[r]);
      pmax = swapmax(pmax) + Tt;
      if (__all(pmax - m_reg < -150.f)) continue_tile = true;
      if (!continue_tile) {
      const float mnt = fmaxf(m_reg, pmax), alpha = ex2(m_reg - mnt); m_reg = mnt;
      const float mn = mnt - Tt;
      float ps = 0.f;
#pragma unroll
      for (int r = 0; r < 16; ++r) { p0[r] = ex2(p0[r] - mn); p1[r] = ex2(p1[r] - mn); ps += p0[r] + p1[r]; }
      ps = swapsum(ps);
      l_reg = l_reg * alpha + ps;
      bf16x8 pa0, pa1, pa2, pa3;
      PK4(p0, 0, pa0); PK4(p0, 8, pa1); PK4(p1, 0, pa2); PK4(p1, 8, pa3);
      if (__any(alpha < 1.f)) { if (hi == 0) al_l[r32] = alpha; asm volatile("s_waitcnt lgkmcnt(0)" ::: "memory");
#pragma unroll
        for (int d = 0; d < NO; ++d)
#pragma unroll
          for (int r = 0; r < 16; ++r) o[d][r] *= al_l[crow(r, hi)]; }
      const int vb = vb0 + cur * 16384;
      pv_one<0>(o[0], vb, pa0, pa1, pa2, pa3); pv_one<1>(o[1], vb, pa0, pa1, pa2, pa3);
      if constexpr (NO == 4) { pv_one<2>(o[2], vb, pa0, pa1, pa2, pa3); pv_one<3>(o[3], vb, pa0, pa1, pa2, pa3); }
      }
    }
    if (more) SWRITE(cur ^ 1);
    __syncthreads();
  }
#undef SLOAD
#undef SWRITE
  if (hi == 0) li_l[r32] = l_reg; asm volatile("s_waitcnt lgkmcnt(0)" ::: "memory");
#pragma unroll
  for (int r = 0; r < 16; ++r) { const float rl = __builtin_amdgcn_rcpf(li_l[crow(r, hi)]);
#pragma unroll
    for (int d = 0; d < NO; ++d) o[d][r] *= rl; }
}
struct BigCtx { int r32, hi, vis_lo, vis_hi, qpos_w; float slope2; const float* tab; float* al_l; };
template <int DQK, int MODE>
__device__ __forceinline__ void bc2_qkt(f32x16& p0, f32x16& p1, const char* Ks, const bf16x8* qr, const BigCtx& c, int t, bf16x8 qx, bf16x8 kx0, bf16x8 kx1) {
  if (MODE == 1) { const bool lookup = (c.qpos_w - (t * 64 + 63)) < 128; const float cc = lookup ? 0.f : c.tab[256];
#pragma unroll
    for (int r = 0; r < 16; ++r) { p0[r] = cc; p1[r] = cc; } }
  else if (MODE == 2) { p0 = __builtin_amdgcn_mfma_f32_32x32x16_bf16(kx0, qx, f32x16{}, 0, 0, 0); p1 = __builtin_amdgcn_mfma_f32_32x32x16_bf16(kx1, qx, f32x16{}, 0, 0, 0); }
  else { p0 = f32x16{}; p1 = f32x16{}; }
#pragma unroll
  for (int dg = 0; dg < DQK / 16; dg += 4) { bf16x8 kfa[4], kfb[4];
#pragma unroll
    for (int d0 = 0; d0 < 4; ++d0) { const int cb = ((dg + d0) * 16 + c.hi * 8) * 2;
      kfa[d0] = *reinterpret_cast<const bf16x8*>(Ks + KSWZ(c.r32, cb)); kfb[d0] = *reinterpret_cast<const bf16x8*>(Ks + KSWZ(32 + c.r32, cb)); }
    asm volatile("s_waitcnt lgkmcnt(0)" ::: "memory");
#pragma unroll
    for (int d0 = 0; d0 < 4; ++d0) { asm volatile("" : "+v"(kfa[d0]), "+v"(kfb[d0]));
      p0 = __builtin_amdgcn_mfma_f32_32x32x16_bf16(kfa[d0], qr[dg + d0], p0, 0, 0, 0); p1 = __builtin_amdgcn_mfma_f32_32x32x16_bf16(kfb[d0], qr[dg + d0], p1, 0, 0, 0); } }
}
template <int MODE>
__device__ __forceinline__ void bc2_part(f32x16& p0, f32x16& p1, const BigCtx& c, int t, float& m_reg, float& mn, float& al) {
  const bool vis = (t >= c.vis_lo) && (t <= c.vis_hi);
  const int rel0 = c.qpos_w + c.r32 - t * 64;
  float Tt = 0.f;
  if (MODE == 1) { if (vis && (c.qpos_w - (t * 64 + 63)) < 128) {
#pragma unroll
      for (int r = 0; r < 16; ++r) { const int i0 = min(rel0 - crow(r, c.hi), 128) + 128, i1 = min(rel0 - crow(r, c.hi) - 32, 128) + 128; p0[r] += c.tab[i0]; p1[r] += c.tab[i1]; } } }
  if (MODE == 2) { Tt = c.slope2 * (float)(t * 64);
    if (t == c.vis_hi) { const float r0f = (float)(rel0 - 4 * c.hi), s2 = 2.f * c.slope2;
#pragma unroll
      for (int r = 0; r < 16; ++r) { const float c0 = (float)((r & 3) + 8 * (r >> 2)); p0[r] += s2 * fminf(r0f - c0, 0.f); p1[r] += s2 * fminf(r0f - c0 - 32.f, 0.f); } } }
  if (!vis) {
#pragma unroll
    for (int r = 0; r < 16; ++r) { p0[r] = -1e30f; p1[r] = -1e30f; } }
  float pmax = p0[0];
#pragma unroll
  for (int r = 1; r < 16; ++r) pmax = fmaxf(pmax, p0[r]);
#pragma unroll
  for (int r = 0; r < 16; ++r) pmax = fmaxf(pmax, p1[r]);
  pmax = swapmax(pmax) + Tt;
  const float mnt = fmaxf(m_reg, pmax); al = ex2(m_reg - mnt); m_reg = mnt; mn = mnt - Tt;
#pragma unroll
  for (int r = 0; r < 16; ++r) p0[r] = ex2(p0[r] - mn);
}
__device__ __forceinline__ void bc2_fin(f32x16& p0, f32x16& p1, float mn, float al, float& l_reg, bf16x8& pa0, bf16x8& pa1, bf16x8& pa2, bf16x8& pa3) {
#pragma unroll
  for (int r = 0; r < 16; ++r) p1[r] = ex2(p1[r] - mn);
  float ps = 0.f;
#pragma unroll
  for (int r = 0; r < 16; ++r) ps += p0[r];
#pragma unroll
  for (int r = 0; r < 16; ++r) ps += p1[r];
  ps = swapsum(ps);
  l_reg = l_reg * al + ps;
  PK4(p0, 0, pa0); PK4(p0, 8, pa1); PK4(p1, 0, pa2); PK4(p1, 8, pa3);
}
template <int NO>
__device__ __forceinline__ void bc2_pv(f32x16 (&o)[NO], int vb, bf16x8 pa0, bf16x8 pa1, bf16x8 pa2, bf16x8 pa3) {
  pv_one<0>(o[0], vb, pa0, pa1, pa2, pa3); pv_one<1>(o[1], vb, pa0, pa1, pa2, pa3);
  if constexpr (NO == 4) { pv_one<2>(o[2], vb, pa0, pa1, pa2, pa3); pv_one<3>(o[3], vb, pa0, pa1, pa2, pa3); }
}
template <int DQK, int DV, int MODE>
__device__ __forceinline__ void big_core2(char* lds, const bf16* __restrict__ Qw, int ldq, const bf16* __restrict__ Kh, int ldk, const bf16* __restrict__ Vh, int ldv,
                                          int t_lo, int t_hi, int vis_lo, int vis_hi, int qpos_w, float slope2, f32x16 (&o)[DV / 32]) {
  int tid = threadIdx.x; asm volatile("" : "+v"(tid));
  const int wid = __builtin_amdgcn_readfirstlane(tid >> 6), lane = tid & 63, r32 = lane & 31, hi = lane >> 5;
  char* K_lds = lds + L_K; char* V_lds = lds + L_V;
  float* al_l = (float*)(lds + L_WS) + wid * 64; float* li_l = al_l + 32;
  constexpr int NQ = DQK / 16, NO = DV / 32, NKL = DQK / 64, NVL = DV / 64, CPRK = DQK / 8, CPRV = DV / 8;
  BigCtx c; c.r32 = r32; c.hi = hi; c.vis_lo = vis_lo; c.vis_hi = vis_hi; c.qpos_w = qpos_w; c.slope2 = slope2; c.tab = (const float*)(lds + L_TAB); c.al_l = al_l;
  bf16x8 qr[NQ];
#pragma unroll
  for (int d0 = 0; d0 < NQ; ++d0) qr[d0] = *reinterpret_cast<const bf16x8*>(Qw + (long)r32 * ldq + d0 * 16 + hi * 8);
#pragma unroll
  for (int d = 0; d < NO; ++d) o[d] = f32x16{};
  float m_reg = -1e29f, l_reg = 0.f;
  const int vb0 = (int)(uintptr_t)V_lds + v_rd_base(lane);
  bf16x8 ks_[NKL], vs_[NVL];
  bf16x8 qx = bf16x8{}, kx0 = bf16x8{}, kx1 = bf16x8{};
  if constexpr (MODE == 2) {
    if (hi == 0) {
      u32x4 wq = {0x3F803F80u, 0x00003F80u, 0u, 0u}; qx = *reinterpret_cast<bf16x8*>(&wq);
      const float v0 = slope2 * (float)r32, v1 = slope2 * (float)(32 + r32);
      const unsigned a1 = cvtpk(v0, 0.f) & 0xffffu; const float r1 = v0 - __uint_as_float(a1 << 16); const unsigned a2 = cvtpk(r1, 0.f) & 0xffffu; const float r2 = r1 - __uint_as_float(a2 << 16); const unsigned a3 = cvtpk(r2, 0.f) & 0xffffu;
      const unsigned b1 = cvtpk(v1, 0.f) & 0xffffu; const float s1 = v1 - __uint_as_float(b1 << 16); const unsigned b2 = cvtpk(s1, 0.f) & 0xffffu; const float s2 = s1 - __uint_as_float(b2 << 16); const unsigned b3 = cvtpk(s2, 0.f) & 0xffffu;
      u32x4 wa = {a1 | (a2 << 16), a3, 0u, 0u}, wb = {b1 | (b2 << 16), b3, 0u, 0u}; kx0 = *reinterpret_cast<bf16x8*>(&wa); kx1 = *reinterpret_cast<bf16x8*>(&wb);
    }
  }
#define SLOAD(t) do { _Pragma("unroll") for (int i = 0; i < NKL; ++i) { const int cc_ = tid + 512 * i; ks_[i] = *reinterpret_cast<const bf16x8*>(Kh + (long)((t) * 64 + cc_ / CPRK) * ldk + (cc_ % CPRK) * 8); } \
                      _Pragma("unroll") for (int i = 0; i < NVL; ++i) { const int cc_ = tid + 512 * i; vs_[i] = *reinterpret_cast<const bf16x8*>(Vh + (long)((t) * 64 + cc_ / CPRV) * ldv + (cc_ % CPRV) * 8); } } while (0)
#define SWRITE(b) do { _Pragma("unroll") for (int i = 0; i < NKL; ++i) { const int cc_ = tid + 512 * i; *reinterpret_cast<bf16x8*>(K_lds + (b) * 16384 + KSWZ(cc_ / CPRK, (cc_ % CPRK) * 16)) = ks_[i]; } \
                       _Pragma("unroll") for (int i = 0; i < NVL; ++i) { const int cc_ = tid + 512 * i; *reinterpret_cast<bf16x8*>(V_lds + (b) * 16384 + v_st(cc_ / CPRV, (cc_ % CPRV) * 8)) = vs_[i]; } } while (0)
#define RESC(a) do { if (__any((a) < 1.f)) { if (hi == 0) al_l[r32] = (a); asm volatile("s_waitcnt lgkmcnt(0)" ::: "memory"); \
    _Pragma("unroll") for (int d = 0; d < NO; ++d) _Pragma("unroll") for (int r = 0; r < 16; ++r) o[d][r] *= al_l[crow(r, hi)]; } } while (0)
  f32x16 pA0, pA1, pB0, pB1; float mnA, mnB, alA, alB; bf16x8 pa0, pa1, pa2, pa3;
  const int NT = t_hi - t_lo;
  SLOAD(t_lo); SWRITE(0); __syncthreads();
  bc2_qkt<DQK, MODE>(pA0, pA1, K_lds, qr, c, t_lo, qx, kx0, kx1); bc2_part<MODE>(pA0, pA1, c, t_lo, m_reg, mnA, alA);
  SLOAD(t_lo + 1); SWRITE(1); __syncthreads();
  for (int j = 1; j + 1 < NT; j += 2) {
    SBAR(); bc2_qkt<DQK, MODE>(pB0, pB1, K_lds + 16384, qr, c, t_lo + j, qx, kx0, kx1);
    bc2_fin(pA0, pA1, mnA, alA, l_reg, pa0, pa1, pa2, pa3); SBAR();
    SLOAD(t_lo + j + 1); SBAR();
    bc2_pv<NO>(o, vb0, pa0, pa1, pa2, pa3); bc2_part<MODE>(pB0, pB1, c, t_lo + j, m_reg, mnB, alB);
    __syncthreads(); SWRITE(0);
    RESC(alB); __syncthreads();
    SBAR(); bc2_qkt<DQK, MODE>(pA0, pA1, K_lds, qr, c, t_lo + j + 1, qx, kx0, kx1);
    bc2_fin(pB0, pB1, mnB, alB, l_reg, pa0, pa1, pa2, pa3); SBAR();
    SLOAD(t_lo + j + 2); SBAR();
    bc2_pv<NO>(o, vb0 + 16384, pa0, pa1, pa2, pa3); bc2_part<MODE>(pA0, pA1, c, t_lo + j + 1, m_reg, mnA, alA);
    __syncthreads(); SWRITE(1);
    RESC(alA); __syncthreads();
  }
  SBAR(); bc2_qkt<DQK, MODE>(pB0, pB1, K_lds + 16384, qr, c, t_hi - 1, qx, kx0, kx1);
  bc2_fin(pA0, pA1, mnA, alA, l_reg, pa0, pa1, pa2, pa3); SBAR();
  bc2_pv<NO>(o, vb0, pa0, pa1, pa2, pa3); bc2_part<MODE>(pB0, pB1, c, t_hi - 1, m_reg, mnB, alB);
  RESC(alB);
  bc2_fin(pB0, pB1, mnB, alB, l_reg, pa0, pa1, pa2, pa3); SBAR();
  bc2_pv<NO>(o, vb0 + 16384, pa0, pa1, pa2, pa3);
  __syncthreads();
#undef SLOAD
#undef SWRITE
#undef RESC
  if (hi == 0) li_l[r32] = l_reg; asm volatile("s_waitcnt lgkmcnt(0)" ::: "memory");
#pragma unroll
  for (int r = 0; r < 16; ++r) { const float rl = __builtin_amdgcn_rcpf(li_l[crow(r, hi)]);
#pragma unroll
    for (int d = 0; d < NO; ++d) o[d][r] *= rl; }
}
template <int DV>
__device__ __forceinline__ void store_tile_bf16(char* stg, bf16* Ow, int ldo, const f32x16 (&o)[DV / 32]) {
  int tid_ = threadIdx.x; asm volatile("" : "+v"(tid_));
  const int lane = tid_ & 63, r32 = lane & 31, hi = lane >> 5;
  constexpr int PITCH = DV * 2, CPR = DV / 8;
#pragma unroll
  for (int d = 0; d < DV / 32; ++d)
#pragma unroll
    for (int r = 0; r < 16; ++r) *(unsigned short*)(stg + crow(r, hi) * PITCH + (d * 32 + r32) * 2) = (unsigned short)(cvtpk(o[d][r], 0.f) & 0xffffu);
  asm volatile("s_waitcnt lgkmcnt(0)" ::: "memory");
  u32x4 rb_[(32 * CPR) / 64];
#pragma unroll
  for (int i = 0; i < (32 * CPR) / 64; ++i) { const int c = i * 64 + lane, row = c / CPR, ch = c % CPR; rb_[i] = *(const u32x4*)(stg + row * PITCH + ch * 16); }
  asm volatile("s_waitcnt lgkmcnt(0)" ::: "memory");
#pragma unroll
  for (int i = 0; i < (32 * CPR) / 64; ++i) { const int c = i * 64 + lane, row = c / CPR, ch = c % CPR; *(u32x4*)(Ow + (long)row * ldo + ch * 8) = rb_[i]; }
  asm volatile("s_waitcnt lgkmcnt(0)" ::: "memory");
}

__device__ __forceinline__ const float* uniform_ptr(const float* p) {
  const unsigned long long v = (unsigned long long)p; const unsigned lo = __builtin_amdgcn_readfirstlane((unsigned)v), hi = __builtin_amdgcn_readfirstlane((unsigned)(v >> 32));
  return (const float*)(const __attribute__((address_space(1))) float*)(((unsigned long long)hi << 32) | lo);
}
template <int DQK, int DV, int MODE, int VB, bool PRE>
__device__ __forceinline__ void small_core(char* lds, const bf16* __restrict__ Qp, int ldq, const float* __restrict__ Kc, const float* __restrict__ Vc, int n0,
                                           const float* __restrict__ Kn, const float* __restrict__ Vn, int pitch, int qpos0, int kpos_c, int kpos_n, float slope2) {
  int tid = threadIdx.x; asm volatile("" : "+v"(tid));
  const int wid = __builtin_amdgcn_readfirstlane(tid >> 6), lane = tid & 63, r32 = lane & 31, hi = lane >> 5;
  float* Osum = (float*)(lds + SM_OSUM); float* lsum = (float*)(lds + SM_L); float* mbuf = (float*)(lds + SM_M);
  const float* tab = (const float*)(lds + L_TAB);
  constexpr int NQ = DQK / 16, NO = DV / 32;
  bf16x8 qr[NQ];
#pragma unroll
  for (int d0 = 0; d0 < NQ; ++d0) qr[d0] = *reinterpret_cast<const bf16x8*>(Qp + (long)r32 * ldq + d0 * 16 + hi * 8);
  f32x16 o[NO];
#pragma unroll
  for (int d = 0; d < NO; ++d) o[d] = f32x16{};
  float m_reg = -1e30f, l_reg = 0.f;
  const int nt0 = n0 / 32, nt = nt0 + (Kn ? 1 : 0);
  for (int t = wid; t < nt; t += 8) {
    const bool isnew = t >= nt0;
    const float* Kp = uniform_ptr(isnew ? Kn : Kc + (long)t * 32 * pitch);
    const float* Vp = uniform_ptr(isnew ? Vn : Vc + (long)t * 32 * pitch);
    const unsigned koffB = (unsigned)(r32 * pitch + hi * 8) * 4u, voffB = (unsigned)(4 * hi * pitch + r32) * 4u;
    const int kbase = isnew ? kpos_n : kpos_c + t * 32;
    float vfp[PRE ? DV / 32 : 1][2][8];
    if constexpr (PRE) {
#pragma unroll
      for (int db = 0; db < DV / 32; ++db)
#pragma unroll
        for (int s = 0; s < 2; ++s)
#pragma unroll
          for (int j = 0; j < 8; ++j) vfp[db][s][j] = *(const float*)((const char*)(Vp + (long)(16 * s + 8 * (j >> 2) + (j & 3)) * pitch + db * 32) + voffB);
    }
    const int rel0 = qpos0 + r32 - kbase;
    f32x16 p;
    bool lookup = false;
    if (MODE == 1) { lookup = (qpos0 - (kbase + 31)) < 128; const float c = lookup ? 0.f : tab[256];
#pragma unroll
      for (int r = 0; r < 16; ++r) p[r] = c; }
    else p = f32x16{};
#pragma unroll
    for (int kc = 0; kc < NQ; kc += 4) {
      f32x4 kf[4][2];
#pragma unroll
      for (int d0 = 0; d0 < 4; ++d0) { const char* kp = (const char*)(Kp + (kc + d0) * 16) + koffB; kf[d0][0] = *(const f32x4*)kp; kf[d0][1] = *(const f32x4*)(kp + 16); }
#pragma unroll
      for (int d0 = 0; d0 < 4; ++d0) { u32x4 w = {cvtpk(kf[d0][0][0], kf[d0][0][1]), cvtpk(kf[d0][0][2], kf[d0][0][3]), cvtpk(kf[d0][1][0], kf[d0][1][1]), cvtpk(kf[d0][1][2], kf[d0][1][3])};
        p = __builtin_amdgcn_mfma_f32_32x32x16_bf16(*reinterpret_cast<bf16x8*>(&w), qr[kc + d0], p, 0, 0, 0); }
      asm volatile("" ::: "memory");
    }
    if (MODE == 1) { if (lookup) {
#pragma unroll
        for (int r = 0; r < 16; ++r) p[r] += tab[min(rel0 - crow(r, hi), 128) + 128]; } }
    if (MODE == 2) {
#pragma unroll
      for (int r = 0; r < 16; ++r) p[r] -= slope2 * fabsf((float)(rel0 - crow(r, hi))); }
    float pmax = p[0];
#pragma unroll
    for (int r = 1; r < 16; ++r) pmax = fmaxf(pmax, p[r]);
    pmax = swapmax(pmax);
    const float mn = fmaxf(m_reg, pmax), alpha = ex2(m_reg - mn); m_reg = mn;
    float ps = 0.f;
#pragma unroll
    for (int r = 0; r < 16; ++r) { p[r] = ex2(p[r] - mn); ps += p[r]; }
    ps = swapsum(ps);
    l_reg = l_reg * alpha + ps;
#pragma unroll
    for (int d = 0; d < NO; ++d)
#pragma unroll
      for (int r = 0; r < 16; ++r) o[d][r] *= alpha;
    bf16x8 pb[2];
#pragma unroll
    for (int s = 0; s < 2; ++s) { u32x4 w = {cvtpk(p[8 * s + 0], p[8 * s + 1]), cvtpk(p[8 * s + 2], p[8 * s + 3]), cvtpk(p[8 * s + 4], p[8 * s + 5]), cvtpk(p[8 * s + 6], p[8 * s + 7])}; pb[s] = *reinterpret_cast<bf16x8*>(&w); }
    if constexpr (PRE) {
#pragma unroll
      for (int db = 0; db < NO; ++db)
#pragma unroll
        for (int s = 0; s < 2; ++s) { u32x4 w = {cvtpk(vfp[db][s][0], vfp[db][s][1]), cvtpk(vfp[db][s][2], vfp[db][s][3]), cvtpk(vfp[db][s][4], vfp[db][s][5]), cvtpk(vfp[db][s][6], vfp[db][s][7])};
          o[db] = __builtin_amdgcn_mfma_f32_32x32x16_bf16(*reinterpret_cast<bf16x8*>(&w), pb[s], o[db], 0, 0, 0); }
    } else {
#pragma unroll
    for (int dh = 0; dh < NO; dh += VB) {
      float vf[VB][2][8];
#pragma unroll
      for (int db = 0; db < VB; ++db)
#pragma unroll
        for (int s = 0; s < 2; ++s)
#pragma unroll
          for (int j = 0; j < 8; ++j) vf[db][s][j] = *(const float*)((const char*)(Vp + (long)(16 * s + 8 * (j >> 2) + (j & 3)) * pitch + (dh + db) * 32) + voffB);
#pragma unroll
      for (int db = 0; db < VB; ++db)
#pragma unroll
        for (int s = 0; s < 2; ++s) { u32x4 w = {cvtpk(vf[db][s][0], vf[db][s][1]), cvtpk(vf[db][s][2], vf[db][s][3]), cvtpk(vf[db][s][4], vf[db][s][5]), cvtpk(vf[db][s][6], vf[db][s][7])};
          o[dh + db] = __builtin_amdgcn_mfma_f32_32x32x16_bf16(*reinterpret_cast<bf16x8*>(&w), pb[s], o[dh + db], 0, 0, 0); }
      asm volatile("" ::: "memory");
    }
    }
  }
  if (hi == 0) mbuf[wid * 32 + r32] = m_reg;
  __syncthreads();
  float mx = mbuf[r32];
#pragma unroll
  for (int w = 1; w < 8; ++w) mx = fmaxf(mx, mbuf[w * 32 + r32]);
  const float sc = ex2(m_reg - mx);
  float* slab = (float*)(lds + SM_OSUM + wid * SM_SLAB); float* lpart = (float*)(lds + SM_LP);
  if (hi == 0) lpart[wid * 32 + r32] = l_reg * sc;
#pragma unroll
  for (int d = 0; d < NO; ++d)
#pragma unroll
    for (int r = 0; r < 16; ++r) slab[(d * 32 + crow(r, hi)) * 33 + r32] = o[d][r] * sc;
  __syncthreads();
  for (int e = tid; e < DV * 33; e += 512) { float t_[8];
#pragma unroll
    for (int w = 0; w < 8; ++w) t_[w] = Osum[w * (SM_SLAB / 4) + e];
    Osum[e] = ((t_[0] + t_[1]) + (t_[2] + t_[3])) + ((t_[4] + t_[5]) + (t_[6] + t_[7])); }
  if (tid < 32) { float a = lpart[tid];
#pragma unroll
    for (int w = 1; w < 8; ++w) a += lpart[w * 32 + tid];
    lsum[tid] = a; }
  __syncthreads();
}
#undef SBAR
}
constexpr int NWAVES = 8, NTHREADS = 512;
constexpr int LDSCTL_OFF = 139264, LDS_BYTES = 147456;
constexpr int CW_BAR = 4096;
static_assert(att::L_END <= LDSCTL_OFF && LDSCTL_OFF + 256 <= LDS_BYTES, "LDS map");
#define GAS __attribute__((address_space(1)))
#define LAS __attribute__((address_space(3)))
typedef unsigned short bf16;
typedef unsigned v4u __attribute__((ext_vector_type(4)));
typedef float f32x4 __attribute__((ext_vector_type(4)));
typedef short bf16x8 __attribute__((ext_vector_type(8)));
typedef GAS unsigned gu32;
typedef GAS unsigned long long gu64;
#define RLX_AGENT __ATOMIC_RELAXED, __HIP_MEMORY_SCOPE_AGENT
#define LDS_WAIT() asm volatile("s_waitcnt lgkmcnt(0)" ::: "memory")
#define VM_WAIT() asm volatile("s_waitcnt vmcnt(0)" ::: "memory")
__device__ __forceinline__ unsigned long long rt() { return __builtin_amdgcn_s_memrealtime(); }
__device__ __forceinline__ unsigned f2bf(float f) { unsigned u = __builtin_bit_cast(unsigned, f); return (u + 0x7fffu + ((u >> 16) & 1u)) >> 16; }
__device__ __forceinline__ unsigned pk2(float lo, float hi) { return f2bf(lo) | (f2bf(hi) << 16); }

#define XB_TMO      128
#define XB_XCNT(j)  (256  + 64 * (j))
#define XB_XSUB(j)  (1280 + 64 * (j))
#define XB_XGEN(j)  (2304 + 64 * (j))
#define XB_TOP      3328
#define XB_TOPGEN   3392
#define XCD_BAR_WORDS 3456
#define XB_SPIN_CAP (1u << 18)

__device__ __forceinline__ unsigned xb_ld(unsigned* p)              { return __hip_atomic_load(p, __ATOMIC_RELAXED, __HIP_MEMORY_SCOPE_AGENT); }
__device__ __forceinline__ unsigned xb_add(unsigned* p, unsigned v) { return __hip_atomic_fetch_add(p, v, __ATOMIC_RELAXED, __HIP_MEMORY_SCOPE_AGENT); }
__device__ __forceinline__ unsigned xb_xcc_id() { return (unsigned)__builtin_amdgcn_s_getreg((3 << 11) | 20) & 0xFu; }
#define XB_SPIN(cond, bar) do { unsigned _sp = 0; while (cond) { __builtin_amdgcn_s_sleep(1); \
    if ((++_sp & 255u) == 0u) { if (xb_ld(&(bar)[XB_TMO])) break; if (_sp > XB_SPIN_CAP) { atomicAdd(&(bar)[XB_TMO], 1u); break; } } } } while (0)

struct XcdBarrier {
    unsigned* bar; unsigned x;
    volatile LAS unsigned* st;
};

__device__ __forceinline__ XcdBarrier xcd_barrier_post(unsigned* bar, volatile LAS unsigned* st) {
    XcdBarrier b; b.bar = bar; b.x = xb_xcc_id(); b.st = st;
    if (threadIdx.x == 0) (void)xb_add(&bar[XB_XCNT(b.x)], 1u);
    return b;
}
__device__ __forceinline__ void xcd_barrier_complete(unsigned* bar, unsigned x, unsigned& nloc, unsigned& nx) {
    const unsigned G = gridDim.x * gridDim.y * gridDim.z;
    unsigned sum, cnt, mine, sp = 0u;
    for (;;) {
        sum = 0u; cnt = 0u; mine = 0u;
#pragma unroll
        for (unsigned j = 0; j < 16; ++j) { const unsigned c = xb_ld(&bar[XB_XCNT(j)]); sum += c; cnt += (c > 0u) ? 1u : 0u; mine = (j == x) ? c : mine; }
        if (sum == G) break;
        __builtin_amdgcn_s_sleep(1);
        if ((++sp & 255u) == 0u) { if (xb_ld(&bar[XB_TMO])) break; if (sp > XB_SPIN_CAP) { atomicAdd(&bar[XB_TMO], 1u); break; } }
    }
    nloc = mine > 0u ? mine : 1u; nx = cnt > 0u ? cnt : 1u;
}

__device__ __forceinline__ void xcd_barrier(const XcdBarrier& b) {
    asm volatile("s_waitcnt vmcnt(0)" ::: "memory");
    __syncthreads();
    if (threadIdx.x == 0) {
        unsigned* bar = b.bar;
        __builtin_amdgcn_s_waitcnt(0);
        unsigned nloc = b.st[0], nx = b.st[1];
        if (nloc == 0u) { xcd_barrier_complete(bar, b.x, nloc, nx); b.st[0] = nloc; b.st[1] = nx; }
        const unsigned old = xb_add(&bar[XB_XSUB(b.x)], 1u);
        const unsigned gen = old / nloc;
        if (old + 1u == (gen + 1u) * nloc) {
            __builtin_amdgcn_fence(__ATOMIC_RELEASE, "agent");
            asm volatile("s_waitcnt vmcnt(0)" ::: "memory");
            const unsigned og = xb_add(&bar[XB_TOP], 1u);
            const unsigned tg = og / nx;
            if (og + 1u == (tg + 1u) * nx) xb_add(&bar[XB_TOPGEN], 1u);
            else XB_SPIN(xb_ld(&bar[XB_TOPGEN]) == tg, bar);
            __builtin_amdgcn_fence(__ATOMIC_ACQUIRE, "agent");
            xb_add(&bar[XB_XGEN(b.x)], 1u);
            asm volatile("s_waitcnt vmcnt(0)" ::: "memory");
        } else {
            XB_SPIN(xb_ld(&bar[XB_XGEN(b.x)]) == gen, bar);
            __builtin_amdgcn_fence(__ATOMIC_ACQUIRE, "agent");
            asm volatile("s_waitcnt vmcnt(0)" ::: "memory");
        }
    }
    __syncthreads();
}

struct Args { const float* in[21]; float* out; unsigned char* ws; };
enum { I_XP = 0, I_XS, I_MEM, I_CAK, I_CAV, I_CBK, I_CBV, I_CMK, I_CMV, I_NG, I_WGU, I_WDN, I_WIN, I_RB, I_DL, I_SG, I_WOUT, I_MNG, I_WCQ, I_WCKV, I_WCO };

template <int X> __device__ __forceinline__ float lane_xor(float v) {
    return __int_as_float(__builtin_amdgcn_ds_swizzle(__float_as_int(v), (X << 10) | 0x1f));
}
__device__ __forceinline__ float wave_sum(float v) {
    v += lane_xor<1>(v); v += lane_xor<2>(v); v += lane_xor<4>(v); v += lane_xor<8>(v); v += lane_xor<16>(v);
    auto rr = __builtin_amdgcn_permlane32_swap(__float_as_uint(v), __float_as_uint(v), false, false);
    return __uint_as_float(rr[0]) + __uint_as_float(rr[1]);
}
__device__ __forceinline__ void transpose_item(const float* W, int K, int N, int k0, int ns0, bf16* WT, int nd0, LAS float* scr, int lane, const float* gain) {
    float wv[32];
    const float* wp = W + (size_t)(k0 + (lane >> 5)) * N + ns0 + (lane & 31);
#pragma unroll
    for (int i = 0; i < 32; ++i) wv[i] = wp[(size_t)(2 * i) * N];
    if (gain) { float gv[32]; const float* gp = gain + k0 + (lane >> 5);
#pragma unroll
        for (int i = 0; i < 32; ++i) gv[i] = gp[2 * i];
#pragma unroll
        for (int i = 0; i < 32; ++i) wv[i] *= gv[i]; }
#pragma unroll
    for (int i = 0; i < 32; ++i) scr[(2 * i + (lane >> 5)) * 33 + (lane & 31)] = wv[i];
    LDS_WAIT(); asm volatile("" ::: "memory");
    const int c = lane & 7;
#pragma unroll
    for (int j = 0; j < 4; ++j) { const int n = (lane >> 3) + 8 * j; const LAS float* s = scr + (8 * c) * 33 + n;
        v4u o; o.x = pk2(s[0 * 33], s[1 * 33]); o.y = pk2(s[2 * 33], s[3 * 33]); o.z = pk2(s[4 * 33], s[5 * 33]); o.w = pk2(s[6 * 33], s[7 * 33]);
        *(GAS v4u*)(WT + (size_t)(nd0 + n) * K + k0 + 8 * c) = o; }
    LDS_WAIT(); asm volatile("" ::: "memory");
}
__device__ __forceinline__ void norm_row(const float* xrow, const float* g, bf16* orow, int lane) {
    const GAS f32x4* xr = (const GAS f32x4*)xrow + lane; const GAS f32x4* gr = (const GAS f32x4*)g + lane;
    f32x4 v[4], gv[4]; float s = 0.f;
#pragma unroll
    for (int j = 0; j < 4; ++j) { v[j] = xr[64 * j]; gv[j] = gr[64 * j]; }
#pragma unroll
    for (int j = 0; j < 4; ++j) s += (v[j].x * v[j].x + v[j].y * v[j].y) + (v[j].z * v[j].z + v[j].w * v[j].w);
    const float r = rsqrtf(wave_sum(s) * (1.f / DM) + EPS);
    GAS unsigned long long* o8 = (GAS unsigned long long*)orow + lane;
#pragma unroll
    for (int j = 0; j < 4; ++j) { const f32x4 gg = gv[j];
        o8[64 * j] = (unsigned long long)pk2(v[j].x * r * gg.x, v[j].y * r * gg.y) | ((unsigned long long)pk2(v[j].z * r * gg.z, v[j].w * r * gg.w) << 32); }
}
__device__ __forceinline__ void cast_rows(int m0, int step, const float* xin_p, const float* xin_s, bf16* xb, float* rs, int lane) {
    f32x4 q[4];
#define CR_LOAD(m) do { const float* xs_ = (m) < MP ? xin_p + (size_t)(m) * DM : xin_s + (size_t)((m) - MP) * DM; const GAS f32x4* xr_ = (const GAS f32x4*)xs_ + lane; \
        _Pragma("unroll") for (int j = 0; j < 4; ++j) q[j] = xr_[64 * j]; } while (0)
    if (m0 < MTOT) CR_LOAD(m0);
    for (int m = m0; m < MTOT; m += step) {
        f32x4 v[4]; float s = 0.f;
#pragma unroll
        for (int j = 0; j < 4; ++j) { v[j] = q[j]; s += (v[j].x * v[j].x + v[j].y * v[j].y) + (v[j].z * v[j].z + v[j].w * v[j].w); }
        if (m + step < MTOT) CR_LOAD(m + step);
        const float r = rsqrtf(wave_sum(s) * (1.f / DM) + EPS);
        GAS unsigned long long* o8 = (GAS unsigned long long*)(xb + (size_t)m * DM) + lane;
#pragma unroll
        for (int j = 0; j < 4; ++j) o8[64 * j] = (unsigned long long)pk2(v[j].x, v[j].y) | ((unsigned long long)pk2(v[j].z, v[j].w) << 32);
        if (lane == 0) rs[m] = r;
    }
#undef CR_LOAD
}
template <int NSK>
__device__ __forceinline__ void resid_rows(int m0, int step, bool from_input, const float* xin_p, const float* xin_s, const bf16* ybase, bf16* xb, float* rs, float* xf,
                                           const float* gpost, float w, bool last, int lane, const float* ypart) {
    const GAS f32x4* gp = (const GAS f32x4*)gpost + lane;
    f32x4 gpv[4];
#pragma unroll
    for (int j = 0; j < 4; ++j) gpv[j] = gp[64 * j];
    f32x4 xq[4]; unsigned long long xbq[4], yq[4];
#define RR_LOAD(m) do { const GAS unsigned long long* yr_ = (const GAS unsigned long long*)(ybase + (size_t)(m) * DM) + lane; \
        if (from_input) { const float* xs_ = (m) < MP ? xin_p + (size_t)(m) * DM : xin_s + (size_t)((m) - MP) * DM; const GAS f32x4* xr_ = (const GAS f32x4*)xs_ + lane; \
            _Pragma("unroll") for (int j = 0; j < 4; ++j) { xq[j] = xr_[64 * j]; yq[j] = yr_[64 * j]; } } \
        else { const GAS unsigned long long* xr_ = (const GAS unsigned long long*)(xb + (size_t)(m) * DM) + lane; \
            _Pragma("unroll") for (int j = 0; j < 4; ++j) { xbq[j] = xr_[64 * j]; yq[j] = yr_[64 * j]; } } } while (0)
#define RR_UNPK(dst, q) do { const unsigned lo_ = (unsigned)(q), hi_ = (unsigned)((q) >> 32); \
        dst.x = __uint_as_float(lo_ << 16); dst.y = __uint_as_float(lo_ & 0xffff0000u); dst.z = __uint_as_float(hi_ << 16); dst.w = __uint_as_float(hi_ & 0xffff0000u); } while (0)
    if (m0 < MP) RR_LOAD(m0);
    for (int m = m0; m < MP; m += step) {
        f32x4 x[4], y[4]; float s = 0.f;
#pragma unroll
        for (int j = 0; j < 4; ++j) { if (from_input) x[j] = xq[j]; else RR_UNPK(x[j], xbq[j]); RR_UNPK(y[j], yq[j]);
            s += (y[j].x * y[j].x + y[j].y * y[j].y) + (y[j].z * y[j].z + y[j].w * y[j].w); }
        if (m + step < MP) RR_LOAD(m + step);
        const float ry = rsqrtf(wave_sum(s) * (1.f / DM) + EPS) * w;
        float s2 = 0.f;
#pragma unroll
        for (int j = 0; j < 4; ++j) { x[j] = x[j] + y[j] * gpv[j] * ry; s2 += (x[j].x * x[j].x + x[j].y * x[j].y) + (x[j].z * x[j].z + x[j].w * x[j].w); }
        if (last) { GAS f32x4* xo = (GAS f32x4*)(xf + (size_t)m * DM) + lane;
#pragma unroll
            for (int j = 0; j < 4; ++j) xo[64 * j] = x[j]; }
        else { GAS unsigned long long* o8 = (GAS unsigned long long*)(xb + (size_t)m * DM) + lane;
#pragma unroll
            for (int j = 0; j < 4; ++j) o8[64 * j] = (unsigned long long)pk2(x[j].x, x[j].y) | ((unsigned long long)pk2(x[j].z, x[j].w) << 32);
            const float rx = rsqrtf(wave_sum(s2) * (1.f / DM) + EPS);
            if (lane == 0) rs[m] = rx; }
    }
    for (int m = MP + m0; m < MTOT; m += step) {
        f32x4 x[4], y[4]; float s = 0.f;
        if (from_input) { const GAS f32x4* xr_ = (const GAS f32x4*)(xin_s + (size_t)(m - MP) * DM) + lane;
#pragma unroll
            for (int j = 0; j < 4; ++j) x[j] = xr_[64 * j]; }
        else { const GAS unsigned long long* xr_ = (const GAS unsigned long long*)(xb + (size_t)m * DM) + lane; unsigned long long q_[4];
#pragma unroll
            for (int j = 0; j < 4; ++j) q_[j] = xr_[64 * j];
#pragma unroll
            for (int j = 0; j < 4; ++j) RR_UNPK(x[j], q_[j]); }
#pragma unroll
        for (int j = 0; j < 4; ++j) y[j] = (f32x4){0.f, 0.f, 0.f, 0.f};
#pragma unroll
        for (int k0 = 0; k0 < NSK; k0 += 6) { f32x4 t_[6][4];
#pragma unroll
            for (int kk = 0; kk < 6; ++kk) if (k0 + kk < NSK) { const GAS f32x4* yr_ = (const GAS f32x4*)(ypart + ((size_t)(k0 + kk) * MS + (m - MP)) * DM) + lane;
#pragma unroll
                for (int j = 0; j < 4; ++j) t_[kk][j] = yr_[64 * j]; }
#pragma unroll
            for (int kk = 0; kk < 6; ++kk) if (k0 + kk < NSK) {
#pragma unroll
                for (int j = 0; j < 4; ++j) y[j] = y[j] + t_[kk][j]; } }
#pragma unroll
        for (int j = 0; j < 4; ++j) s += (y[j].x * y[j].x + y[j].y * y[j].y) + (y[j].z * y[j].z + y[j].w * y[j].w);
        const float ry = rsqrtf(wave_sum(s) * (1.f / DM) + EPS) * w;
        float s2 = 0.f;
#pragma unroll
        for (int j = 0; j < 4; ++j) { x[j] = x[j] + y[j] * gpv[j] * ry; s2 += (x[j].x * x[j].x + x[j].y * x[j].y) + (x[j].z * x[j].z + x[j].w * x[j].w); }
        if (last) { GAS f32x4* xo = (GAS f32x4*)(xf + (size_t)m * DM) + lane;
#pragma unroll
            for (int j = 0; j < 4; ++j) xo[64 * j] = x[j]; }
        else { GAS unsigned long long* o8 = (GAS unsigned long long*)(xb + (size_t)m * DM) + lane;
#pragma unroll
            for (int j = 0; j < 4; ++j) o8[64 * j] = (unsigned long long)pk2(x[j].x, x[j].y) | ((unsigned long long)pk2(x[j].z, x[j].w) << 32);
            const float rx = rsqrtf(wave_sum(s2) * (1.f / DM) + EPS);
            if (lane == 0) rs[m] = rx; }
    }
#undef RR_LOAD
#undef RR_UNPK
}
#ifndef REP_PC
#define REP_PC 1
#endif
#ifndef REP_SC
#define REP_SC 1
#endif
#ifndef BIGC_BAND
#define BIGC_BAND big_core
#endif
#ifndef BIGC_DIFF
#define BIGC_DIFF big_core
#endif
#ifndef BIGC_CROSS
#define BIGC_CROSS big_core2
#endif
#ifndef REP_GEMM
#define REP_GEMM 1
#endif
#ifndef REP_GEMM
#define REP_GEMM 1
#endif
#ifndef REP_GU
#define REP_GU REP_GEMM
#endif
#ifndef REP_DN
#define REP_DN REP_GEMM
#endif
#ifndef REP_IN
#define REP_IN REP_GEMM
#endif
#ifndef REP_OUT
#define REP_OUT REP_GEMM
#endif
#ifndef REP_CQ
#define REP_CQ REP_GEMM
#endif
#ifndef REP_CO
#define REP_CO REP_GEMM
#endif
#ifndef GEMM_ALIGN
#define GEMM_ALIGN true
#endif
#ifndef REP_PRO
#define REP_PRO 1
#endif
#ifndef REP_ATT
#define REP_ATT 1
#endif
#ifndef REP_A
#define REP_A REP_ATT
#endif
#ifndef REP_B
#define REP_B REP_ATT
#endif
#ifndef REP_C
#define REP_C REP_ATT
#endif
#ifndef EN_ALL
#define EN_ALL 1
#endif
#ifndef EN_SDIFF
#define EN_SDIFF EN_ALL
#endif
#ifndef EN_SBAND
#define EN_SBAND EN_ALL
#endif
#ifndef EN_PBAND
#define EN_PBAND EN_ALL
#endif
#ifndef EN_PDIFF
#define EN_PDIFF EN_ALL
#endif
#ifndef EN_SCROSS
#define EN_SCROSS EN_ALL
#endif
#ifndef EN_PCROSS
#define EN_PCROSS EN_ALL
#endif
#ifndef EN_GEMM
#define EN_GEMM EN_ALL
#endif
#ifndef EN_GU1
#define EN_GU1 EN_GEMM
#endif
#ifndef EN_DN1
#define EN_DN1 EN_GEMM
#endif
#ifndef EN_WIN_
#define EN_WIN_ EN_GEMM
#endif
#ifndef EN_WOUT_
#define EN_WOUT_ EN_GEMM
#endif
#ifndef EN_WCQ_
#define EN_WCQ_ EN_GEMM
#endif
#ifndef EN_WCO_
#define EN_WCO_ EN_GEMM
#endif
#ifndef EN_GU2
#define EN_GU2 EN_GEMM
#endif
#ifndef EN_DN2
#define EN_DN2 EN_GEMM
#endif
#ifndef EN_MEMKV
#define EN_MEMKV EN_GEMM
#endif

__device__ __forceinline__ unsigned long long karg_u64(int byte_off) {
    unsigned long long v; const unsigned long long ka = (unsigned long long)__builtin_amdgcn_kernarg_segment_ptr();
    asm volatile("s_load_dwordx2 %0, %1, %2\n\ts_waitcnt lgkmcnt(0)" : "=s"(v) : "s"(ka), "i"(byte_off) : "memory");
    return v;
}
#define INP(i) ((const float*)(const GAS float*)karg_u64(8 * (i)))
#define OUTP() ((float*)(GAS float*)karg_u64(168))
#define WSP() ((unsigned char*)(GAS unsigned char*)karg_u64(176))
#define WGU ((bf16*)(WSP() + WS_WGU))
#define WDN ((bf16*)(WSP() + WS_WDN))
#define WIN ((bf16*)(WSP() + WS_WIN))
#define WOUT ((bf16*)(WSP() + WS_WOUT))
#define WCQ ((bf16*)(WSP() + WS_WCQ))
#define WCKV ((bf16*)(WSP() + WS_WCKV))
#define WCO ((bf16*)(WSP() + WS_WCO))
#define XN ((bf16*)(WSP() + WS_XN))
#define ACT ((bf16*)(WSP() + WS_ACT))
#define Y ((bf16*)(WSP() + WS_Y))
#define QKV ((bf16*)(WSP() + WS_QKV))
#define MIX ((bf16*)(WSP() + WS_MIX))
#define QC ((bf16*)(WSP() + WS_QC))
#define OC ((bf16*)(WSP() + WS_OC))
#define MEMN ((bf16*)(WSP() + WS_MEMN))
#define MKV ((bf16*)(WSP() + WS_MKV))
#define OS ((float*)(WSP() + WS_OS))
#define RS ((float*)(WSP() + WS_RS))
#define YP ((float*)(WSP() + WS_YP))
#define out OUTP()
static_assert(sizeof(Args) == 184, "kernarg layout");

__global__ void __launch_bounds__(NTHREADS, 2) fwd_kernel(Args args) {
    extern __shared__ __attribute__((aligned(16))) unsigned char lds[];
    LAS unsigned char* ldsl = (LAS unsigned char*)lds;
    char* ldsg = (char*)lds;
#define FRESH_IDS() int G = G0, bx = bx0, vcu = vcu0; asm volatile("" : "+s"(G), "+s"(bx), "+s"(vcu)); const int NGW = G * NWAVES; (void)NGW; (void)bx; (void)vcu
#define FRESH_TID() FRESH_IDS(); int tid = threadIdx.x; asm volatile("" : "+v"(tid)); const int lane = tid & 63, wave = __builtin_amdgcn_readfirstlane(tid >> 6), gw = vcu * NWAVES + wave; (void)lane; (void)gw
    const int G0 = gridDim.x, bx0 = blockIdx.x;
    const int vcu0 = (G0 % 8 == 0) ? (bx0 % 8) * (G0 / 8) + bx0 / 8 : bx0;
    { FRESH_TID(); for (int u = tid; u < (LDS_BYTES - LDSCTL_OFF) / 4; u += NTHREADS) ((LAS unsigned*)(ldsl + LDSCTL_OFF))[u] = 0u; }
    __syncthreads();
    (void)xcd_barrier_post((unsigned*)(WSP() + WS_CTL) + CW_BAR, (volatile LAS unsigned*)(ldsl + LDSCTL_OFF) + 8);
#define GRID_BAR() do { XcdBarrier b_; b_.bar = (unsigned*)(WSP() + WS_CTL) + CW_BAR; b_.x = xb_xcc_id(); b_.st = (volatile LAS unsigned*)(ldsl + LDSCTL_OFF) + 8; xcd_barrier(b_); } while (0)

#define CONVERT_ITEMS(LY, I0, I1, W0, NW) do { LAS float* scr = (LAS float*)(ldsl + wave * 16384); \
        for (int it = (I0) + (W0); it < (I1); it += (NW)) { int r = it; \
            if (r < 5632) { const int mi = (LY) * 2 + r / 2816, rr = r % 2816, kb = rr / 176, nb = rr % 176, nd0 = nb * 32, pn = nd0 >> 8, wi = nd0 & 255, bj = wi >> 7, j0 = wi & 127; \
                transpose_item(INP(I_WGU) + (size_t)mi * DM * NGU, DM, NGU, kb * 64, bj * DFF + 128 * pn + j0, WGU + (size_t)mi * NGU * DM, nd0, scr, lane, INP(I_NG) + (size_t)((mi >> 1) * 8 + (mi & 1) * 6) * DM); continue; } r -= 5632; \
            if (r < 2816) { const int mi = (LY) * 2 + r / 1408, rr = r % 1408, kb = rr / 32, nb = rr % 32; \
                transpose_item(INP(I_WDN) + (size_t)mi * DFF * DM, DFF, DM, kb * 64, nb * 32, WDN + (size_t)mi * DM * DFF, nb * 32, scr, lane, nullptr); continue; } r -= 2816; \
            if (r < 1536) { const int mi = (LY), kb = r / 96, nb = r % 96; \
                transpose_item(INP(I_WIN) + (size_t)mi * DM * NIN, DM, NIN, kb * 64, nb * 32, WIN + (size_t)mi * NIN * DM, nb * 32, scr, lane, INP(I_NG) + (size_t)(mi * 8 + 2) * DM); continue; } r -= 1536; \
            if (r < 512) { const int mi = (LY), kb = r / 32, nb = r % 32; \
                transpose_item(INP(I_WOUT) + (size_t)mi * DM * DM, DM, DM, kb * 64, nb * 32, WOUT + (size_t)mi * DM * DM, nb * 32, scr, lane, nullptr); continue; } r -= 512; \
            if (r < 256) { const int mi = (LY), kb = r / 16, nb = r % 16; \
                transpose_item(INP(I_WCQ) + (size_t)mi * DM * 512, DM, 512, kb * 64, nb * 32, WCQ + (size_t)mi * 512 * DM, nb * 32, scr, lane, INP(I_NG) + (size_t)(mi * 8 + 4) * DM); continue; } r -= 256; \
            { const int mi = (LY), kb = r / 32, nb = r % 32; \
                transpose_item(INP(I_WCO) + (size_t)mi * 512 * DM, 512, DM, kb * 64, nb * 32, WCO + (size_t)mi * DM * 512, nb * 32, scr, lane, nullptr); } } } while (0)
    constexpr int CV_ITEMS = 5632 + 2816 + 1536 + 512 + 256 + 256;
    for (int prep_ = 0; prep_ < REP_PRO; ++prep_) {
        if (prep_) GRID_BAR();
        FRESH_TID();
        CONVERT_ITEMS(0, 0, CV_ITEMS, gw, NGW);
        { LAS float* scr = (LAS float*)(ldsl + wave * 16384);
          for (int r = gw; r < 1024; r += NGW) { const int mi = r / 512, rr = r % 512, kb = rr / 32, nb = rr % 32;
            transpose_item(INP(I_WCKV) + (size_t)mi * DM * DM, DM, DM, kb * 64, nb * 32, WCKV + (size_t)mi * DM * DM, nb * 32, scr, lane, nullptr); } }
        cast_rows(gw, NGW, INP(I_XP), INP(I_XS), XN, RS, lane);
        { const float* const mem_ = INP(I_MEM); const float* const mg_ = INP(I_MNG); bf16* const mn_ = MEMN;
          for (int m = gw; m < 2 * MMEM; m += NGW) { const int l = m / MMEM, r = m % MMEM; norm_row(mem_ + (size_t)r * DM, mg_ + l * DM, mn_ + (size_t)m * DM, lane); } }
    }
    GRID_BAR();

#define GEMM_STATIC(REPN, Aptr, Bptr, Nn, Kk, EpiT, EpiObj) do { for (int rep_ = 0; rep_ < (REPN); ++rep_) { if (rep_) GRID_BAR(); FRESH_IDS(); pg8::Gemm g_{(const pg8::bf16_t*)(Aptr), (const pg8::bf16_t*)(Bptr), MTOT, (Nn), (Kk), 0}; pg8::StaticOrder S_; S_.init(MTOT, (Nn), G, bx); \
        pg8::gemm_phase<EpiT, pg8::StaticOrder, GEMM_ALIGN, true>(ldsl, g_, S_, (EpiObj)); } } while (0)
#define GEMM_SPLIT(REPN, Aptr, Bptr, Kk, SKk) do { for (int rep_ = 0; rep_ < (REPN); ++rep_) { if (rep_) GRID_BAR(); FRESH_IDS(); \
        { pg8::Gemm g_{(const pg8::bf16_t*)(Aptr), (const pg8::bf16_t*)(Bptr), MP, DM, (Kk), 0}; pg8::StaticOrder S_; S_.init(MP, DM, G, bx); pg8::EpiPlain E_{(pg8::bf16_t*)Y, DM, 1.0f, nullptr}; \
          pg8::gemm_phase<pg8::EpiPlain, pg8::StaticOrder, true, true>(ldsl, g_, S_, E_); } \
        { pg8::Gemm g_{(const pg8::bf16_t*)(Aptr), (const pg8::bf16_t*)(Bptr), MTOT, DM, (Kk), (Kk) / (SKk)}; pg8::SplitOrder S_; S_.init(MP / 256, MS / 256, DM / 256, (SKk), G, bx); \
          pg8::EpiPartial E_{YP, DM, MP, (size_t)MS * DM}; pg8::gemm_phase<pg8::EpiPartial, pg8::SplitOrder, true, true>(ldsl, g_, S_, E_); } } } while (0)
#define THIN(XSRC_IS_INPUT, GPOST, WGT, LAST, NSK) do { FRESH_TID(); \
        resid_rows<NSK>(gw, NGW, (XSRC_IS_INPUT), INP(I_XP), INP(I_XS), Y, XN, RS, out, (GPOST), (WGT), (LAST), lane, YP); } while (0)

#define BAND_UNITS(U0, NU) do { int hprev_ = -1; for (int i_ = 0; EN_PBAND && i_ < (NU); ++i_) { \
        const int u = (U0) + i_; if (u >= PB * 8 * 16) break; \
        const int bh = u >> 4, qb = u & 15, b = bh >> 3, h = bh & 7, q0 = qb * 256; const size_t rowbase = (size_t)b * PT; \
        if (h != hprev_) { hprev_ = h; if (tid < 257) ((float*)(ldsg + att::L_TAB))[tid] = INP(I_RB)[(size_t)(l * 8 + h) * 257 + tid] * LOG2E; } \
        const int cw = 4 * qb + (wave >> 1); \
        att::f32x16 o[2]; \
        att::BIGC_BAND<64, 64, 1>(ldsg, (const att::bf16*)QKV + (rowbase + q0 + wave * 32) * NIN + h * 64, NIN, (const att::bf16*)QKV + rowbase * NIN + 512 + h * 64, NIN, \
                                 (const att::bf16*)QKV + rowbase * NIN + 1024 + h * 64, NIN, max(0, 4 * qb - 8), 4 * qb + 4, cw - 8, cw, q0 + wave * 32, 0.f, o); \
        att::store_tile_bf16<64>(ldsg + wave * 4096, (att::bf16*)MIX + (rowbase + q0 + wave * 32) * DM + h * 64, DM, o); \
        __syncthreads(); } } while (0)
constexpr int BAND_B0 = 3, BAND_B1 = 1, BAND_INB = 64 * (BAND_B0 + BAND_B1);
    for (int l = 0; l < DEPTH; ++l) {
        const float* ng = INP(I_NG) + (size_t)l * 8 * DM;
        if (EN_GU1) { pg8::EpiSwiGLU E{(pg8::bf16_t*)ACT, DFF, RS}; GEMM_STATIC(REP_GU, XN, WGU + (size_t)(l * 2 + 0) * NGU * DM, NGU, DM, pg8::EpiSwiGLU, E); }
        if (EN_MEMKV && l == 0) {
#pragma unroll
            for (int ml = 0; ml < 2; ++ml) { FRESH_IDS(); pg8::Gemm g_{(const pg8::bf16_t*)(MEMN + (size_t)ml * MMEM * DM), (const pg8::bf16_t*)(WCKV + (size_t)ml * DM * DM), MMEM, DM, DM, 0};
                pg8::SubsetOrder S_; S_.init(MMEM / 256, 4, 32, bx - 88 - 32 * ml); pg8::EpiMemKV E{(pg8::bf16_t*)(MKV + (size_t)ml * MMEM * 1024), out, ml};
                pg8::gemm_phase<pg8::EpiMemKV, pg8::SubsetOrder, true, true>(ldsl, g_, S_, E); }
        }
        if (l == 0 && bx0 >= 152) { FRESH_TID(); CONVERT_ITEMS(1, 0, 5632, (bx - 152) * NWAVES + wave, (G - 152) * NWAVES); }
        GRID_BAR();
        if (EN_DN1) GEMM_SPLIT(REP_DN, ACT, WDN + (size_t)(l * 2 + 0) * DM * DFF, DFF, 11);
        GRID_BAR();
        THIN(l == 0, ng + 1 * DM, 0.5f, false, 11);
        GRID_BAR();
        if (EN_WIN_) { pg8::EpiQKV E{(pg8::bf16_t*)QKV, out, l, RS}; GEMM_STATIC(REP_IN, XN, WIN + (size_t)l * NIN * DM, NIN, DM, pg8::EpiQKV, E); }
        if (l == 0 && bx0 >= 48) { FRESH_TID(); CONVERT_ITEMS(1, 5632, CV_ITEMS, (bx - 48) * NWAVES + wave, (G - 48) * NWAVES); }
        GRID_BAR();
        for (int rep_ = 0; rep_ < REP_A; ++rep_) {
            if (rep_) GRID_BAR();
            FRESH_TID();
            for (int ord_ = 0; ord_ < 2; ++ord_) {
            if ((ord_ == 0) != (((vcu >> 3) & 1) != 0)) {
            if (EN_SDIFF && vcu < SB * 4 * 2) {
                const int b = vcu >> 3, h = (vcu >> 1) & 3, mp = vcu & 1;
                const float slope2 = exp2f(-2.0f * (float)(h + 1)) * LOG2E;
                const float* Kc = INP(I_CBK) + ((size_t)(l * SB + b) * PAST) * 512 + h * 128 + mp * 64;
                const float* Vc = INP(I_CBV) + ((size_t)(l * SB + b) * PAST) * 512 + h * 128;
                const float* Kn = out + O_SBK + ((size_t)l * MS + b * ST) * 512 + h * 128 + mp * 64;
                const float* Vn = out + O_SBV + ((size_t)l * MS + b * ST) * 512 + h * 128;
                att::small_core<64, 128, 2, 4, true>(ldsg, (const att::bf16*)QKV + (size_t)(MP + b * ST) * NIN + 1536 + h * 128 + mp * 64, NIN, Kc, Vc, PAST, Kn, Vn, 512, PAST, 0, PAST, slope2);
                const float* Osum = (const float*)(ldsg + att::SM_OSUM); const float* lsum = (const float*)(ldsg + att::SM_L);
                float* od = OS + (size_t)mp * MS * 512 + (size_t)(b * ST) * 512 + h * 128;
                for (int i = tid; i < 32 * 128; i += NTHREADS) { const int q = i >> 7, d = i & 127; od[(size_t)q * 512 + d] = Osum[d * 33 + q] / lsum[q]; }
                __syncthreads();
            }
            if (EN_SBAND && vcu < SB * 8) {
                const int b = vcu >> 3, h = vcu & 7;
                if (tid < 257) ((float*)(ldsg + att::L_TAB))[tid] = INP(I_RB)[(size_t)(l * 8 + h) * 257 + tid] * LOG2E;
                __syncthreads();
                const float* Kc = INP(I_CAK) + ((size_t)(l * SB + b) * WA) * 512 + h * 64;
                const float* Vc = INP(I_CAV) + ((size_t)(l * SB + b) * WA) * 512 + h * 64;
                const float* Kn = out + O_SAK + ((size_t)l * MS + b * ST) * 512 + h * 64;
                const float* Vn = out + O_SAV + ((size_t)l * MS + b * ST) * 512 + h * 64;
                att::small_core<64, 64, 1, 2, true>(ldsg, (const att::bf16*)QKV + (size_t)(MP + b * ST) * NIN + h * 64, NIN, Kc, Vc, WA, Kn, Vn, 512, PAST, PAST - WA, PAST, 0.f);
                const float* Osum = (const float*)(ldsg + att::SM_OSUM); const float* lsum = (const float*)(ldsg + att::SM_L);
                bf16* od = MIX + (size_t)(MP + b * ST) * DM + h * 64;
                for (int i = tid; i < 32 * 64; i += NTHREADS) { const int q = i >> 6, d = i & 63; od[(size_t)q * DM + d] = (bf16)f2bf(Osum[d * 33 + q] / lsum[q]); }
                __syncthreads();
            }
            } else {
            { const int na_ = 3, ua_ = BAND_INB + vcu * 3; BAND_UNITS(ua_, na_); }
                    }
            }
        }
        GRID_BAR();
        for (int rep_ = 0; rep_ < REP_B; ++rep_) {
            if (rep_) GRID_BAR();
            FRESH_TID();
            const float lam_init = 0.8f - 0.6f * expf(-0.3f * (float)l);
            const float* dl = INP(I_DL) + (size_t)l * 256;
            const float lam = expf(wave_sum(dl[lane] * dl[64 + lane])) - expf(wave_sum(dl[128 + lane] * dl[192 + lane])) + lam_init;
            const float* sg = INP(I_SG) + (size_t)l * 128;
            const float gsc = 1.0f - lam_init;
            if (EN_PDIFF && vcu < PB * 4 * 8) {
                const int bh = vcu >> 3, sidx = vcu & 7, b = bh >> 2, h = bh & 3; const size_t rowbase = (size_t)b * PT;
                const float slope2 = exp2f(-2.0f * (float)(h + 1)) * LOG2E;
                const int r32 = lane & 31, hi = lane >> 5;
                for (int half = 0; half < 2; ++half) {
                    const int qb = half == 0 ? sidx : 15 - sidx, q0 = qb * 256, cw = 4 * qb + (wave >> 1);
                    unsigned short* stash = (unsigned short*)(ldsg + att::L_STASH + wave * 8192);
                    att::f32x16 o[4];
                    for (int mp = 0; mp < 2; ++mp) {
                        att::BIGC_DIFF<64, 128, 2>(ldsg, (const att::bf16*)QKV + (rowbase + q0 + wave * 32) * NIN + 1536 + h * 128 + mp * 64, NIN,
                                                  (const att::bf16*)QKV + rowbase * NIN + 2048 + h * 128 + mp * 64, NIN, (const att::bf16*)QKV + rowbase * NIN + 2560 + h * 128, NIN,
                                                  0, 4 * qb + 4, 0, cw, q0 + wave * 32, slope2, o);
                        if (mp == 0) {
#pragma unroll
                            for (int d = 0; d < 4; ++d)
#pragma unroll
                                for (int r = 0; r < 16; ++r) stash[(d * 16 + r) * 64 + lane] = (unsigned short)(att::cvtpk(o[d][r], 0.f) & 0xffffu);
                        }
                    }
                    asm volatile("s_waitcnt lgkmcnt(0)" ::: "memory");
#pragma unroll
                    for (int r = 0; r < 16; ++r) { float ss = 0.f;
#pragma unroll
                        for (int d = 0; d < 4; ++d) { const float v = att::bf2f(stash[(d * 16 + r) * 64 + lane]) - lam * o[d][r]; o[d][r] = v; ss += v * v; }
                        ss += lane_xor<1>(ss); ss += lane_xor<2>(ss); ss += lane_xor<4>(ss); ss += lane_xor<8>(ss); ss += lane_xor<16>(ss);
                        const float rs = rsqrtf(ss * (1.f / 128.f) + EPS) * gsc;
#pragma unroll
                        for (int d = 0; d < 4; ++d) o[d][r] *= rs; }
#pragma unroll
                    for (int d = 0; d < 4; ++d) { const float gg = sg[d * 32 + r32];
#pragma unroll
                        for (int r = 0; r < 16; ++r) o[d][r] *= gg; }
                    (void)hi;
                    att::store_tile_bf16<128>(ldsg + wave * 8192, (att::bf16*)MIX + (rowbase + q0 + wave * 32) * DM + 512 + h * 128, DM, o);
                    __syncthreads();
                }
            }
            { const int hd_ = (vcu >> 3) & 3, jr_ = (vcu >> 5) * 8 + (vcu & 7);
              if (hd_ == 0) BAND_UNITS(jr_ * BAND_B0, BAND_B0); else if (hd_ == 1) BAND_UNITS(64 * BAND_B0 + jr_ * BAND_B1, BAND_B1); }
            const float* const os_ = OS; bf16* const mix_ = MIX;
            for (int it = gw; it < MS * 4; it += NGW) {
                const int row = it >> 2, h = it & 3; const size_t off = (size_t)row * 512 + h * 128 + 2 * lane;
                const float2 a = *(const float2*)(os_ + off), c = *(const float2*)(os_ + (size_t)MS * 512 + off);
                const float v0 = a.x - lam * c.x, v1 = a.y - lam * c.y;
                const float rs = rsqrtf(wave_sum(v0 * v0 + v1 * v1) * (1.f / 128.f) + EPS) * gsc;
                *(unsigned*)(mix_ + (size_t)(MP + row) * DM + 512 + h * 128 + 2 * lane) = pk2(v0 * rs * sg[2 * lane], v1 * rs * sg[2 * lane + 1]);
            }
        }
        GRID_BAR();
        if (EN_WOUT_) GEMM_SPLIT(REP_OUT, MIX, WOUT + (size_t)l * DM * DM, DM, 4);
        GRID_BAR();
        THIN(false, ng + 3 * DM, 1.0f, false, 4);
        GRID_BAR();
        if (EN_WCQ_) { pg8::EpiPlain E{(pg8::bf16_t*)QC, 512, QS128, RS}; GEMM_STATIC(REP_CQ, XN, WCQ + (size_t)l * 512 * DM, 512, DM, pg8::EpiPlain, E); }
        GRID_BAR();
        for (int rep_ = 0; rep_ < REP_C; ++rep_) {
            if (rep_) GRID_BAR();
            FRESH_TID();
            for (int rsc_ = 0; rsc_ < REP_SC; ++rsc_)
            if (EN_SCROSS && vcu < SB * 4) {
                const int b = vcu >> 2, h = vcu & 3;
                const float* Kc = INP(I_CMK) + ((size_t)(l * SB + b) * NMEM) * 512 + h * 128;
                const float* Vc = INP(I_CMV) + ((size_t)(l * SB + b) * NMEM) * 512 + h * 128;
                att::small_core<128, 128, 0, 1, false>(ldsg, (const att::bf16*)QC + (size_t)(MP + b * ST) * 512 + h * 128, 512, Kc, Vc, NMEM, nullptr, nullptr, 512, 0, 0, 0, 0.f);
                const float* Osum = (const float*)(ldsg + att::SM_OSUM); const float* lsum = (const float*)(ldsg + att::SM_L);
                bf16* od = OC + (size_t)(MP + b * ST) * 512 + h * 128;
                for (int i = tid; i < 32 * 128; i += NTHREADS) { const int q = i >> 7, d = i & 127; od[(size_t)q * 512 + d] = (bf16)f2bf(Osum[d * 33 + q] / lsum[q]); }
                __syncthreads();
            }
            for (int i2 = 0; EN_PCROSS && i2 < 2 * REP_PC; ++i2) { const int i = i2 & 1;
                const int u = i * G + vcu; if (u >= PB * 4 * 16) break;
                const int bh = u >> 4, qb = u & 15, b = bh >> 2, h = bh & 3, q0 = qb * 256; const size_t rowbase = (size_t)b * PT;
                const att::bf16* Kh = (const att::bf16*)MKV + ((size_t)l * MMEM + (size_t)b * NMEM) * 1024 + h * 128;
                att::f32x16 o[4];
                att::BIGC_CROSS<128, 128, 0>(ldsg, (const att::bf16*)QC + (rowbase + q0 + wave * 32) * 512 + h * 128, 512, Kh, 1024, Kh + 512, 1024, 0, 4, 0, 3, 0, 0.f, o);
                att::store_tile_bf16<128>(ldsg + wave * 8192, (att::bf16*)OC + (rowbase + q0 + wave * 32) * 512 + h * 128, 512, o);
                __syncthreads();
            }
        }
        GRID_BAR();
        if (EN_WCO_) GEMM_SPLIT(REP_CO, OC, WCO + (size_t)l * DM * 512, 512, 2);
        GRID_BAR();
        THIN(false, ng + 5 * DM, 1.0f, false, 2);
        GRID_BAR();
        if (EN_GU2) { pg8::EpiSwiGLU E{(pg8::bf16_t*)ACT, DFF, RS}; GEMM_STATIC(REP_GU, XN, WGU + (size_t)(l * 2 + 1) * NGU * DM, NGU, DM, pg8::EpiSwiGLU, E); }
        GRID_BAR();
        if (EN_DN2) GEMM_SPLIT(REP_DN, ACT, WDN + (size_t)(l * 2 + 1) * DM * DFF, DFF, 11);
        GRID_BAR();
        THIN(false, ng + 7 * DM, 0.5f, l + 1 == DEPTH, 11);
        if (l + 1 < DEPTH) GRID_BAR();
    }
}

#undef out
#undef Y
extern "C" void kernel_launch(void* const* d_in, const int* in_sizes, int n_in, void* d_out, int out_size, void* d_ws, size_t ws_size, hipStream_t stream) {
    static int ready = 0;
    if (ready == 0) {
        if (n_in != 21 || (size_t)out_size != O_END || ws_size < WS_END) { fprintf(stderr, "kernel_launch: unexpected shapes: n_in %d out %d ws %zu\n", n_in, out_size, ws_size); ready = -1; return; }
        if (hipFuncSetAttribute((const void*)fwd_kernel, hipFuncAttributeMaxDynamicSharedMemorySize, LDS_BYTES) != hipSuccess) { fprintf(stderr, "kernel_launch: hipFuncSetAttribute failed\n"); ready = -1; return; }
        int per_cu = 0;
        if (hipOccupancyMaxActiveBlocksPerMultiprocessor(&per_cu, (const void*)fwd_kernel, NTHREADS, LDS_BYTES) != hipSuccess || per_cu < 1)
            fprintf(stderr, "kernel_launch: note: occupancy query reports %d workgroups per CU\n", per_cu);
        (void)hipGetLastError();
        ready = 1;
    }
    if (ready < 0) return;
    (void)hipMemsetAsync((char*)d_ws + WS_CTL, 0, CTL_ZERO_BYTES, stream);
    Args a{};
    for (int i = 0; i < 21; ++i) a.in[i] = (const float*)d_in[i];
    a.out = (float*)d_out; a.ws = (unsigned char*)d_ws;
    hipLaunchKernelGGL(fwd_kernel, dim3(256), dim3(NTHREADS), LDS_BYTES, stream, a);
    const hipError_t le = hipPeekAtLastError();
    if (le != hipSuccess) fprintf(stderr, "kernel_launch: launch failed: %s\n", hipGetErrorName(le));
}
```
